# Optimizing an MI355X kernel written in HIP

```python
import math
import jax, jax.numpy as jnp
from jax import lax
import numpy as np

D_MODEL = 1024
BATCH = 4
SEQ = 4096
DEPTH = 1

ATT_HEADS = 8
ATT_KV_HEADS = 2
ATT_HEAD_DIM = 64
ATT_GROUP = ATT_HEADS // ATT_KV_HEADS
WINDOW = 128
BLOCK = 128
ML_HEADS = 4
ML_HEAD_DIM = 128
ML_CHUNK = 64
CONV_WIDTH = 4
MEM_LEN = 256
X_HEADS = 4
X_HEAD_DIM = 128
N_GROUPS = 4
EXPERTS_PER_GROUP = 8
N_EXPERTS = N_GROUPS * EXPERTS_PER_GROUP
TOP_K = 2
D_EXPERT = 512
MOE_BLOCK = 128
EPS = 1e-6

ATT_Q = ATT_HEADS * ATT_HEAD_DIM
ATT_KV = ATT_KV_HEADS * ATT_HEAD_DIM
ML_W = ML_HEADS * ML_HEAD_DIM
MIX_WIDTH = ATT_Q + ML_W
IN_SPLITS = [ATT_Q, ATT_KV, ATT_KV, 2 * ML_W, ML_W, ML_W, 2 * ML_HEADS]
IN_COLS = sum(IN_SPLITS)
IN_OFFSETS = [int(v) for v in np.cumsum(IN_SPLITS)[:-1]]

kernel_name = 'hybrid_swa_mlstm_hmoe'


def rms_norm(x, g):
    xf = x.astype(jnp.float32)
    y = xf * lax.rsqrt(jnp.mean(xf * xf, axis=-1, keepdims=True) + EPS)
    return (y * g.astype(jnp.float32)).astype(x.dtype)


def alibi_slopes(n):
    return jnp.exp2(-8.0 * jnp.arange(1, n + 1, dtype=jnp.float32) / n)


def causal_depthwise_conv(x, w, b):
    c = x.shape[-1]
    y = lax.conv_general_dilated(x, w[:, None, :], window_strides=(1,),
                                 padding=[(CONV_WIDTH - 1, 0)],
                                 dimension_numbers=('NWC', 'WIO', 'NWC'),
                                 feature_group_count=c)
    return y + b


def sliding_window_gqa(q, k, v, sinks):
    bsz, s = q.shape[0], q.shape[1]
    nb = s // BLOCK
    qb = q.reshape(bsz, nb, BLOCK, ATT_KV_HEADS, ATT_GROUP, ATT_HEAD_DIM)

    def with_prev(t):
        t = t.reshape(bsz, nb, BLOCK, ATT_KV_HEADS, ATT_HEAD_DIM)
        prev = jnp.pad(t[:, :-1], ((0, 0), (1, 0), (0, 0), (0, 0), (0, 0)))
        return jnp.concatenate([prev, t], axis=2)

    kk, vv = with_prev(k), with_prev(v)
    scores = jnp.einsum('bnqkgd,bnskd->bkgnqs', qb, kk).astype(jnp.float32)
    scores = scores * (1.0 / math.sqrt(ATT_HEAD_DIM))
    dist = (jnp.arange(BLOCK)[:, None] + BLOCK) - jnp.arange(2 * BLOCK)[None, :]
    in_band = (dist >= 0) & (dist < WINDOW)
    pad_key = (jnp.arange(nb)[:, None, None] == 0) & (jnp.arange(2 * BLOCK)[None, None, :] < BLOCK)
    valid = in_band[None] & ~pad_key
    slopes = alibi_slopes(ATT_HEADS).reshape(ATT_KV_HEADS, ATT_GROUP)[:, :, None, None, None]
    logits = scores - slopes * dist.astype(jnp.float32)
    logits = jnp.where(valid, logits, -jnp.inf)
    sink = sinks.astype(jnp.float32).reshape(ATT_KV_HEADS, ATT_GROUP)[:, :, None, None, None]
    mx = jnp.maximum(logits.max(axis=-1, keepdims=True), sink)
    e = jnp.exp(logits - mx)
    p = e / (e.sum(axis=-1, keepdims=True) + jnp.exp(sink - mx))
    out = jnp.einsum('bkgnqs,bnskd->bnqkgd', p.astype(v.dtype), vv)
    return out.reshape(bsz, s, ATT_Q)


def mlstm_chunk_step(carry, inp):
    c_st, n_st, m_st = carry
    q, k, v, ig, lf = inp
    L = q.shape[2]
    b = jnp.cumsum(lf, axis=-1)
    causal = jnp.tril(jnp.ones((L, L), dtype=bool))
    log_d = jnp.where(causal, b[..., :, None] - b[..., None, :] + ig[..., None, :], -jnp.inf)
    m_inter = b + m_st[..., None]
    m_t = jnp.maximum(m_inter, log_d.max(axis=-1))
    s = jnp.einsum('bhtd,bhsd->bhts', q, k) * jnp.exp(log_d - m_t[..., None])
    a_inter = jnp.exp(m_inter - m_t)
    num = jnp.einsum('bhts,bhsd->bhtd', s, v) + a_inter[..., None] * jnp.einsum('bhtk,bhkv->bhtv', q, c_st)
    den = s.sum(axis=-1) + a_inter * jnp.einsum('bhtk,bhk->bht', q, n_st)
    h = num / jnp.maximum(jnp.abs(den), jnp.exp(-m_t))[..., None]
    b_last = b[..., -1]
    log_w = b_last[..., None] - b + ig
    m_new = jnp.maximum(b_last + m_st, log_w.max(axis=-1))
    w = jnp.exp(log_w - m_new[..., None])
    decay = jnp.exp(b_last + m_st - m_new)
    c_new = decay[..., None, None] * c_st + jnp.einsum('bhsk,bhsv->bhkv', k * w[..., None], v)
    n_new = decay[..., None] * n_st + jnp.einsum('bhs,bhsk->bhk', w, k)
    return (c_new, n_new, m_new), h


def mlstm(q, k, v, i_pre, f_pre):
    bsz, s, nh, dh = q.shape
    nc = s // ML_CHUNK
    f32 = jnp.float32
    def chunks(t):
        return t.astype(f32).reshape(bsz, nc, ML_CHUNK, nh, dh).transpose(1, 0, 3, 2, 4)
    def gchunks(t):
        return t.reshape(bsz, nc, ML_CHUNK, nh).transpose(1, 0, 3, 2)
    qc = chunks(q)
    kc = chunks(k) * (1.0 / math.sqrt(dh))
    vc = chunks(v)
    igc = gchunks(i_pre.astype(f32))
    lfc = gchunks(jax.nn.log_sigmoid(f_pre.astype(f32)))
    init = (jnp.zeros((bsz, nh, dh, dh), f32), jnp.zeros((bsz, nh, dh), f32), jnp.zeros((bsz, nh), f32))
    _, hs = lax.scan(mlstm_chunk_step, init, (qc, kc, vc, igc, lfc))
    return hs.transpose(1, 0, 3, 2, 4).reshape(bsz, s, nh, dh)


def memory_cross_attention(xn, memn, w_cq, w_ckv, w_co):
    bsz, s, _ = xn.shape
    q = (xn @ w_cq).reshape(bsz, s, X_HEADS, X_HEAD_DIM)
    kv = (memn @ w_ckv).reshape(bsz, memn.shape[1], 2, X_HEADS, X_HEAD_DIM)
    k, v = kv[:, :, 0], kv[:, :, 1]
    sc = jnp.einsum('bshd,bmhd->bhsm', q, k).astype(jnp.float32) * (1.0 / math.sqrt(X_HEAD_DIM))
    p = jax.nn.softmax(sc, axis=-1)
    o = jnp.einsum('bhsm,bmhd->bshd', p.astype(v.dtype), v).reshape(bsz, s, X_HEADS * X_HEAD_DIM)
    return o @ w_co


def hierarchical_moe(xn, w_rg, b_rg, w_re, b_re, w_g, w_u, w_d):
    bsz, s, d = xn.shape
    t = bsz * s
    xt = xn.reshape(t, d)
    g_logits = (xt @ w_rg).astype(jnp.float32) + b_rg.astype(jnp.float32)
    g_prob = jax.nn.softmax(g_logits, axis=-1)
    g_sel = jnp.argmax(g_logits, axis=-1)
    g_w = jnp.take_along_axis(g_prob, g_sel[:, None], axis=-1)
    e_logits = ((xt @ w_re).astype(jnp.float32) + b_re.astype(jnp.float32)).reshape(t, N_GROUPS, EXPERTS_PER_GROUP)
    e_in = jnp.take_along_axis(e_logits, g_sel[:, None, None], axis=1)[:, 0]
    top_v, top_i = lax.top_k(e_in, TOP_K)
    top_p = jax.nn.softmax(top_v, axis=-1) * g_w
    expert_idx = (g_sel[:, None] * EXPERTS_PER_GROUP + top_i).reshape(-1)
    gates = top_p.reshape(-1)
    n_assign = t * TOP_K
    token_idx = jnp.arange(n_assign) // TOP_K
    order = jnp.argsort(expert_idx)
    sorted_e = expert_idx[order]
    counts = jnp.bincount(expert_idx, length=N_EXPERTS)
    padded = (counts + MOE_BLOCK - 1) // MOE_BLOCK * MOE_BLOCK
    pad_end = jnp.cumsum(padded)
    pad_start = pad_end - padded
    start = jnp.cumsum(counts) - counts
    dest = pad_start[sorted_e] + (jnp.arange(n_assign) - start[sorted_e])
    n_blocks = -(-n_assign // MOE_BLOCK) + N_EXPERTS
    x_pad = jnp.zeros((n_blocks * MOE_BLOCK, d), xt.dtype).at[dest].set(xt[token_idx[order]])
    block_e = jnp.minimum(jnp.searchsorted(pad_end, jnp.arange(n_blocks) * MOE_BLOCK, side='right'), N_EXPERTS - 1)

    def expert_block(args):
        xb, e = args
        hb = jax.nn.silu(xb @ w_g[e]) * (xb @ w_u[e])
        return hb @ w_d[e]

    y_pad = lax.map(expert_block, (x_pad.reshape(n_blocks, MOE_BLOCK, d), block_e)).reshape(-1, d)
    y = y_pad[dest] * gates[order][:, None].astype(y_pad.dtype)
    out = jnp.zeros((t, d), xt.dtype).at[token_idx[order]].add(y)
    return out.reshape(bsz, s, d)


def setup_inputs(seed: int = 0) -> dict:
    key = jax.random.key(seed)
    ks = iter(jax.random.split(key, 40))
    f32 = jnp.float32

    def nrm(shape, scale):
        return jax.random.normal(next(ks), shape, f32) * scale

    def gain(shape):
        return 1.0 + nrm(shape, 0.02)

    L = DEPTH
    x = nrm((BATCH, SEQ, D_MODEL), 1.0)
    mem = nrm((BATCH, MEM_LEN, D_MODEL), 1.0)
    b_i = nrm((L, ML_HEADS), 0.1)
    b_f = jnp.linspace(3.0, 6.0, ML_HEADS, dtype=f32)[None, :] + nrm((L, ML_HEADS), 0.01)
    return {
        'x': x,
        'mem': mem,
        'norm_mix': gain((L, D_MODEL)),
        'w_in': nrm((L, D_MODEL, IN_COLS), D_MODEL ** -0.5),
        'b_gates': jnp.concatenate([b_i, b_f], axis=-1),
        'conv_w': nrm((L, CONV_WIDTH, 2 * ML_W), CONV_WIDTH ** -0.5),
        'conv_b': nrm((L, 2 * ML_W), 0.01),
        'att_sinks': nrm((L, ATT_HEADS), 0.5),
        'norm_att_out': gain((L, ATT_Q)),
        'norm_ml_out': gain((L, ML_W)),
        'w_out': nrm((L, MIX_WIDTH, D_MODEL), MIX_WIDTH ** -0.5),
        'norm_cross': gain((L, D_MODEL)),
        'norm_mem': gain((L, D_MODEL)),
        'w_cq': nrm((L, D_MODEL, X_HEADS * X_HEAD_DIM), D_MODEL ** -0.5),
        'w_ckv': nrm((L, D_MODEL, 2 * X_HEADS * X_HEAD_DIM), D_MODEL ** -0.5),
        'w_co': nrm((L, X_HEADS * X_HEAD_DIM, D_MODEL), (X_HEADS * X_HEAD_DIM) ** -0.5),
        'norm_ffn': gain((L, D_MODEL)),
        'w_router_group': nrm((L, D_MODEL, N_GROUPS), D_MODEL ** -0.5),
        'b_router_group': nrm((L, N_GROUPS), 0.01),
        'w_router_expert': nrm((L, D_MODEL, N_EXPERTS), D_MODEL ** -0.5),
        'b_router_expert': nrm((L, N_EXPERTS), 0.01),
        'w_e_gate': nrm((L, N_EXPERTS, D_MODEL, D_EXPERT), D_MODEL ** -0.5),
        'w_e_up': nrm((L, N_EXPERTS, D_MODEL, D_EXPERT), D_MODEL ** -0.5),
        'w_e_down': nrm((L, N_EXPERTS, D_EXPERT, D_MODEL), D_EXPERT ** -0.5),
        'norm_final': gain((D_MODEL,)),
    }


def reference(x, mem, norm_mix, w_in, b_gates, conv_w, conv_b, att_sinks, norm_att_out,
              norm_ml_out, w_out, norm_cross, norm_mem, w_cq, w_ckv, w_co, norm_ffn,
              w_router_group, b_router_group, w_router_expert, b_router_expert,
              w_e_gate, w_e_up, w_e_down, norm_final):
    bsz, s, _ = x.shape
    for l in range(DEPTH):
        h = rms_norm(x, norm_mix[l])
        proj = h @ w_in[l]
        q_a, k_a, v_a, qk_m, v_m, o_m, g_m = jnp.split(proj, IN_OFFSETS, axis=-1)
        att = sliding_window_gqa(q_a.reshape(bsz, s, ATT_HEADS, ATT_HEAD_DIM),
                                 k_a.reshape(bsz, s, ATT_KV_HEADS, ATT_HEAD_DIM),
                                 v_a.reshape(bsz, s, ATT_KV_HEADS, ATT_HEAD_DIM),
                                 att_sinks[l])
        att = rms_norm(att, norm_att_out[l])
        qk_m = jax.nn.silu(causal_depthwise_conv(qk_m, conv_w[l], conv_b[l]))
        q_m, k_m = jnp.split(qk_m, 2, axis=-1)
        g_m = g_m + b_gates[l]
        i_pre, f_pre = g_m[..., :ML_HEADS], g_m[..., ML_HEADS:]
        hm = mlstm(q_m.reshape(bsz, s, ML_HEADS, ML_HEAD_DIM),
                   k_m.reshape(bsz, s, ML_HEADS, ML_HEAD_DIM),
                   v_m.reshape(bsz, s, ML_HEADS, ML_HEAD_DIM), i_pre, f_pre)
        hm = jax.nn.sigmoid(o_m.astype(jnp.float32)).reshape(bsz, s, ML_HEADS, ML_HEAD_DIM) * hm
        hm = rms_norm(hm.astype(x.dtype), norm_ml_out[l].reshape(ML_HEADS, ML_HEAD_DIM)).reshape(bsz, s, ML_W)
        x = x + jnp.concatenate([att, hm], axis=-1) @ w_out[l]
        x = x + memory_cross_attention(rms_norm(x, norm_cross[l]), rms_norm(mem, norm_mem[l]),
                                       w_cq[l], w_ckv[l], w_co[l])
        x = x + hierarchical_moe(rms_norm(x, norm_ffn[l]), w_router_group[l], b_router_group[l],
                                 w_router_expert[l], b_router_expert[l],
                                 w_e_gate[l], w_e_up[l], w_e_down[l])
    return rms_norm(x, norm_final)
```

```cpp
#include <hip/hip_runtime.h>
#include <cstdio>
#include <cstdint>

#ifndef MK_N_LAUNCHES
#define MK_N_LAUNCHES 1
#endif

#define DEV __device__ __forceinline__
#define LAS __attribute__((address_space(3)))
typedef unsigned short bf16_t;
typedef short bf16x8 __attribute__((ext_vector_type(8)));
typedef float f32x4 __attribute__((ext_vector_type(4)));
typedef unsigned u32x4 __attribute__((ext_vector_type(4)));
typedef unsigned u32x2 __attribute__((ext_vector_type(2)));

constexpr int M = 16384, D = 1024, SEQ = 4096, NBATCH = 4;
constexpr int IN_COLS = 2824, NPAD = 2944;
constexpr int MEMROWS = 1024;
constexpr int NEXP = 32, DEXP = 512;
constexpr float EPS = 1e-6f;
constexpr int NPHASE = 15;

enum { I_X = 0, I_MEM, I_NORM_MIX, I_W_IN, I_B_GATES, I_CONV_W, I_CONV_B, I_SINKS, I_NORM_ATT, I_NORM_ML, I_W_OUT, I_NORM_CROSS, I_NORM_MEM,
       I_W_CQ, I_W_CKV, I_W_CO, I_NORM_FFN, I_W_RG, I_B_RG, I_W_RE, I_B_RE, I_W_EG, I_W_EU, I_W_ED, I_NORM_FINAL, N_IN };

constexpr size_t KiB = 1024, MiB = 1024 * 1024;
constexpr size_t WS_CTL    = 0;
constexpr size_t CTL_BYTES = 64 * KiB;
constexpr size_t WS_RSTD0  = 64 * KiB;
constexpr size_t WS_RSTDM  = 128 * KiB;
constexpr size_t WS_RSTD2  = 192 * KiB;
constexpr size_t WS_GATES  = 256 * KiB;
constexpr size_t WS_SLOTOF = 384 * KiB;
constexpr size_t WS_G      = 512 * KiB;
constexpr size_t WS_SS1    = 1 * MiB;
constexpr size_t WS_LIST   = 2 * MiB;
constexpr size_t WS_SC     = 4 * MiB;
constexpr size_t WS_MP     = 4 * MiB + 16 * KiB;
constexpr size_t WS_UN     = 4 * MiB + 512 * KiB;
constexpr size_t WS_NP     = 5 * MiB;
constexpr size_t WS_WRH    = 6 * MiB;
constexpr size_t WS_WRL    = 6 * MiB + 128 * KiB;
constexpr size_t WS_ATTSS  = 7 * MiB;
constexpr size_t WS_WINT   = 8 * MiB;
constexpr size_t WS_WOUTT  = 14 * MiB;
constexpr size_t WS_WCQT   = 16 * MiB;
constexpr size_t WS_WCKVT  = 17 * MiB;
constexpr size_t WS_WCOT   = 19 * MiB;
constexpr size_t WS_KMEM   = 22 * MiB;
constexpr size_t WS_VMEMT  = 23 * MiB;
constexpr size_t WS_XB     = 24 * MiB;
constexpr size_t WS_MEMB   = 56 * MiB;
constexpr size_t WS_WGT    = 58 * MiB;
constexpr size_t WS_WUT    = 90 * MiB;
constexpr size_t WS_WDT    = 122 * MiB;
constexpr size_t WS_QA     = 154 * MiB;
constexpr size_t WS_KA     = 170 * MiB;
constexpr size_t WS_VAT    = 174 * MiB;
constexpr size_t WS_QKR    = 178 * MiB;
constexpr size_t WS_VMT    = 210 * MiB;
constexpr size_t WS_OM     = 226 * MiB;
constexpr size_t WS_MIX    = 242 * MiB;
constexpr size_t WS_Q      = 154 * MiB;
constexpr size_t WS_O      = 170 * MiB;
constexpr size_t WS_HB     = 154 * MiB;
constexpr size_t WS_Y      = 190 * MiB;
constexpr size_t WS_END    = 274 * MiB;
constexpr int CW_CNT = 0;
constexpr int CW_BAR = 4096;

constexpr int LDS_BYTES = 66560;
constexpr int LDS_ST_OFF = LDS_BYTES - 16;

struct Params { const float* in[N_IN]; float* out; unsigned char* ws; int ph_lo, ph_hi; };

DEV unsigned f2bf(float f) { unsigned u = __builtin_bit_cast(unsigned, f); return (u + 0x7fffu + ((u >> 16) & 1u)) >> 16; }
typedef __bf16 bf16v2_t __attribute__((ext_vector_type(2)));
typedef float f32x2_t __attribute__((ext_vector_type(2)));
DEV unsigned pk2(float lo, float hi) { const f32x2_t v = {lo, hi}; return __builtin_bit_cast(unsigned, __builtin_convertvector(v, bf16v2_t)); }
DEV float bf2f(unsigned h) { return __builtin_bit_cast(float, h << 16); }
DEV float bflo(unsigned w) { return __builtin_bit_cast(float, w << 16); }
DEV float bfhi(unsigned w) { return __builtin_bit_cast(float, w & 0xffff0000u); }
DEV u32x2 pk4(f32x4 v) { u32x2 r; r.x = pk2(v[0], v[1]); r.y = pk2(v[2], v[3]); return r; }
DEV bf16x8 frag_from(u32x2 a, u32x2 b) { u32x4 r; r.x = a.x; r.y = a.y; r.z = b.x; r.w = b.y; return __builtin_bit_cast(bf16x8, r); }
DEV f32x4 mfma16(bf16x8 a, bf16x8 b, f32x4 c) { return __builtin_amdgcn_mfma_f32_16x16x32_bf16(a, b, c, 0, 0, 0); }
typedef long i64x2 __attribute__((ext_vector_type(2)));
DEV f32x4 mfma16_f8(bf16x8 a, bf16x8 b, f32x4 c) {
    const i64x2 av = __builtin_bit_cast(i64x2, a), bv = __builtin_bit_cast(i64x2, b);
    c = __builtin_amdgcn_mfma_f32_16x16x32_fp8_fp8(av[0], bv[0], c, 0, 0, 0);
    return __builtin_amdgcn_mfma_f32_16x16x32_fp8_fp8(av[1], bv[1], c, 0, 0, 0);
}
DEV unsigned pk4_f8(float a, float b, float c, float d) { int r = __builtin_amdgcn_cvt_pk_fp8_f32(a, b, 0, false); r = __builtin_amdgcn_cvt_pk_fp8_f32(c, d, r, true); return (unsigned)r; }
constexpr float F8_WSCALE = 64.f;
constexpr float F8_HSCALE = 16.f;
DEV float sigmoidf_(float x) { return __builtin_amdgcn_rcpf(1.f + __expf(-x)); }
DEV float siluf_(float x) { return x * __builtin_amdgcn_rcpf(1.f + __expf(-x)); }
DEV float wave_sum(float v) {
#pragma unroll
    for (int o = 1; o < 64; o <<= 1) v += __shfl_xor(v, o);
    return v;
}
DEV float wave_max(float v) {
#pragma unroll
    for (int o = 1; o < 64; o <<= 1) v = fmaxf(v, __shfl_xor(v, o));
    return v;
}
#define LDS_FENCE() asm volatile("s_waitcnt lgkmcnt(0)" ::: "memory")
DEV size_t frag16_off(int row, int col, int C32) { return ((size_t)((row >> 4) * C32 + (col >> 5)) * 64 + ((col >> 3) & 3) * 16 + (row & 15)) * 8 + (col & 7); }
DEV size_t fragp_off(int row, int col, int C32) { return ((size_t)((row >> 4) * C32 + (col >> 5)) * 64 + ((col >> 2) & 3) * 16 + (row & 15)) * 8 + ((col >> 4) & 1) * 4 + (col & 3); }
DEV const bf16x8* frag_ptr(const bf16_t* base, int rt, int ct, int C32, int lane) { return (const bf16x8*)(base + ((size_t)(rt * C32 + ct) * 64 + lane) * 8); }

#define XB_TMO      128
#define XB_XCNT(j)  (256  + 64 * (j))
#define XB_XSUB(j)  (1280 + 64 * (j))
#define XB_XGEN(j)  (2304 + 64 * (j))
#define XB_TOP      3328
#define XB_TOPGEN   3392
#define XCD_BAR_WORDS 3456
#define XB_SPIN_CAP (1u << 22)
DEV unsigned xb_ld(unsigned* p)              { return __hip_atomic_load(p, __ATOMIC_RELAXED, __HIP_MEMORY_SCOPE_AGENT); }
DEV unsigned xb_add(unsigned* p, unsigned v) { return __hip_atomic_fetch_add(p, v, __ATOMIC_RELAXED, __HIP_MEMORY_SCOPE_AGENT); }
DEV unsigned xb_xcc_id() { return (unsigned)__builtin_amdgcn_s_getreg((3 << 11) | 20) & 0xFu; }
#define XB_SPIN(cond, bar) do { unsigned _sp = 0; while (cond) { __builtin_amdgcn_s_sleep(1); \
    if ((++_sp & 255u) == 0u) { if (xb_ld(&(bar)[XB_TMO])) break; if (_sp > XB_SPIN_CAP) { atomicAdd(&(bar)[XB_TMO], 1u); break; } } } } while (0)
struct XcdBarrier { unsigned* bar; unsigned x; volatile LAS unsigned* st; };
DEV XcdBarrier xcd_barrier_post(unsigned* bar, volatile LAS unsigned* st) {
    XcdBarrier b; b.bar = bar; b.x = xb_xcc_id(); b.st = st;
    if (threadIdx.x == 0) (void)xb_add(&bar[XB_XCNT(b.x)], 1u);
    return b;
}
DEV void xcd_barrier_complete(unsigned* bar, unsigned x, unsigned& nloc, unsigned& nx) {
    const unsigned G = gridDim.x * gridDim.y * gridDim.z;
    unsigned sum, cnt, mine, sp = 0u;
    for (;;) {
        sum = 0u; cnt = 0u; mine = 0u;
#pragma unroll
        for (unsigned j = 0; j < 16; ++j) { const unsigned c = xb_ld(&bar[XB_XCNT(j)]); sum += c; cnt += (c > 0u) ? 1u : 0u; mine = (j == x) ? c : mine; }
        if (sum == G) break;
        __builtin_amdgcn_s_sleep(1);
        if ((++sp & 255u) == 0u) { if (xb_ld(&bar[XB_TMO])) break; if (sp > XB_SPIN_CAP) { atomicAdd(&bar[XB_TMO], 1u); break; } }
    }
    nloc = mine > 0u ? mine : 1u; nx = cnt > 0u ? cnt : 1u;
}
DEV void xcd_barrier(const XcdBarrier& b) {
    asm volatile("s_waitcnt vmcnt(0)" ::: "memory");
    __syncthreads();
    if (threadIdx.x == 0) {
        unsigned* bar = b.bar;
        __builtin_amdgcn_s_waitcnt(0);
        unsigned nloc = b.st[0], nx = b.st[1];
        if (nloc == 0u) { xcd_barrier_complete(bar, b.x, nloc, nx); b.st[0] = nloc; b.st[1] = nx; }
        const unsigned old = xb_add(&bar[XB_XSUB(b.x)], 1u);
        const unsigned gen = old / nloc;
        if (old + 1u == (gen + 1u) * nloc) {
            __builtin_amdgcn_fence(__ATOMIC_RELEASE, "agent");
            asm volatile("s_waitcnt vmcnt(0)" ::: "memory");
            const unsigned og = xb_add(&bar[XB_TOP], 1u);
            const unsigned tg = og / nx;
            if (og + 1u == (tg + 1u) * nx) xb_add(&bar[XB_TOPGEN], 1u);
            else XB_SPIN(xb_ld(&bar[XB_TOPGEN]) == tg, bar);
            __builtin_amdgcn_fence(__ATOMIC_ACQUIRE, "agent");
            xb_add(&bar[XB_XGEN(b.x)], 1u);
            asm volatile("s_waitcnt vmcnt(0)" ::: "memory");
        } else {
            XB_SPIN(xb_ld(&bar[XB_XGEN(b.x)]) == gen, bar);
            __builtin_amdgcn_fence(__ATOMIC_ACQUIRE, "agent");
            asm volatile("s_waitcnt vmcnt(0)" ::: "memory");
        }
    }
    __syncthreads();
}

template <int NB, int MT, bool TR, bool MID = false, bool AFRAG = false, bool F8 = false, class Epi>
DEV void gemm_tile(unsigned char* lds, const bf16_t* const (&Ar)[MT / 2], const bf16_t* const (&Br)[NB][2], int K, const Epi& epi, int ksplit = -1, int astep = 32) {
    const int tid = threadIdx.x, lane = tid & 63, wid = tid >> 6, wr = wid >> 1, wc = wid & 1, fr = lane & 15, fq = lane >> 4;
    constexpr int RH = MT * 16;
    f32x4 acc[NB][MT][4];
#pragma unroll
    for (int nb = 0; nb < NB; ++nb)
#pragma unroll
        for (int m = 0; m < MT; ++m)
#pragma unroll
            for (int n = 0; n < 4; ++n) acc[nb][m][n] = (f32x4){0.f, 0.f, 0.f, 0.f};
    constexpr int KSUB = (NB == 1 && MT == 4) ? 2 : 1;
    constexpr int ASZ = MT * 2048;
    constexpr int SUBT = ASZ + 8192 * NB;
    constexpr int STAGE = SUBT * KSUB;
    const int nk = K / (32 * KSUB);
#define GT_STAGE(kt_, buf_) do { _Pragma("unroll") for (int su = 0; su < KSUB; ++su) { \
        _Pragma("unroll") for (int i = 0; i < MT / 2; ++i) \
            __builtin_amdgcn_global_load_lds((const unsigned*)(Ar[i] + ((kt_) * KSUB + su) * astep), (LAS unsigned*)(lds + (buf_) * STAGE + su * SUBT + tid * 16 + i * 4096), 16, 0, 0); \
        _Pragma("unroll") for (int i = 0; i < 2; ++i) _Pragma("unroll") for (int nb = 0; nb < NB; ++nb) \
            __builtin_amdgcn_global_load_lds((const unsigned*)(Br[nb][i] + ((kt_) * KSUB + su) * 32), (LAS unsigned*)(lds + (buf_) * STAGE + su * SUBT + ASZ + 8192 * nb + tid * 16 + i * 4096), 16, 0, 0); } } while (0)
    GT_STAGE(0, 0);
    for (int kt = 0; kt < nk; ++kt) {
        const int cur = kt & 1;
        asm volatile("s_waitcnt vmcnt(0)" ::: "memory");
        __syncthreads();
        if (kt + 1 < nk) GT_STAGE(kt + 1, cur ^ 1);
        if constexpr (MID) {
            if (kt * KSUB == ksplit) {
#pragma unroll
                for (int m = 0; m < MT; ++m) { const float ms = epi.midscale(wr * RH + m * 16 + fr);
#pragma unroll
                    for (int n = 0; n < 4; ++n) acc[0][m][n] = acc[0][m][n] * ms; }
            }
        }
#pragma unroll
        for (int su = 0; su < KSUB; ++su) {
            const unsigned char* sb = lds + cur * STAGE + su * SUBT;
            bf16x8 af[MT], bfr[NB][4];
#pragma unroll
            for (int m = 0; m < MT; ++m) af[m] = AFRAG ? *(const bf16x8*)(sb + (wr * MT + m) * 1024 + lane * 16) : *(const bf16x8*)(sb + ((wr * RH + m * 16 + fr) * 32 + fq * 8) * 2);
#pragma unroll
            for (int nb = 0; nb < NB; ++nb)
#pragma unroll
                for (int n = 0; n < 4; ++n) bfr[nb][n] = *(const bf16x8*)(sb + ASZ + 8192 * nb + ((wc * 64 + n * 16 + fr) * 32 + fq * 8) * 2);
#pragma unroll
            for (int nb = 0; nb < NB; ++nb)
#pragma unroll
                for (int m = 0; m < MT; ++m)
#pragma unroll
                    for (int n = 0; n < 4; ++n)
                        acc[nb][m][n] = F8 ? mfma16_f8(bfr[nb][n], af[m], acc[nb][m][n]) : (TR ? mfma16(af[m], bfr[nb][n], acc[nb][m][n]) : mfma16(bfr[nb][n], af[m], acc[nb][m][n]));
        }
    }
#undef GT_STAGE
    if constexpr (Epi::SYNC_EPI) __syncthreads();
    if constexpr (!TR) {
#pragma unroll
        for (int m = 0; m < MT; ++m) {
            const int rl = wr * RH + m * 16 + fr;
            const float rs = epi.rowscale(rl);
            float ss = 0.f;
            f32x4 pre[4];
#pragma unroll
            for (int q = 0; q < 2; ++q) { pre[2 * q] = epi.pre(rl, wc * 64 + q * 32 + 8 * fq); pre[2 * q + 1] = epi.pre(rl, wc * 64 + q * 32 + 8 * fq + 4); }
#pragma unroll
            for (int q = 0; q < 2; ++q) {
                const int cl = wc * 64 + q * 32 + 8 * fq;
                if constexpr (NB == 2) ss += epi.store8x2(rl, cl, acc[0][m][2 * q], acc[0][m][2 * q + 1], acc[1][m][2 * q], acc[1][m][2 * q + 1], rs);
                else ss += epi.store8(rl, cl, acc[0][m][2 * q], acc[0][m][2 * q + 1], rs, pre[2 * q], pre[2 * q + 1]);
            }
            epi.rowend(rl, wc, ss);
            asm volatile("" ::: "memory");
        }
    } else {
#pragma unroll
        for (int m = 0; m < MT; ++m) {
            const int rl = wr * RH + m * 16 + 4 * fq;
            const f32x4 rs = epi.rowscale4(rl);
#pragma unroll
            for (int n = 0; n < 4; ++n) epi.storeT(rl, wc * 64 + n * 16 + fr, acc[0][m][n] * rs);
            asm volatile("" ::: "memory");
        }
    }
}

typedef int i32x8 __attribute__((ext_vector_type(8)));
DEV i32x8 cat32(bf16x8 lo, bf16x8 hi) { const u32x4 a = __builtin_bit_cast(u32x4, lo), b = __builtin_bit_cast(u32x4, hi); i32x8 r; r[0] = (int)a.x; r[1] = (int)a.y; r[2] = (int)a.z; r[3] = (int)a.w; r[4] = (int)b.x; r[5] = (int)b.y; r[6] = (int)b.z; r[7] = (int)b.w; return r; }
template <int NB, int NT, bool AFRAG, class Epi>
DEV void gemm_tile_f8(unsigned char* lds, const bf16_t* const (&Ar)[2], const bf16_t* const (&Br)[NB][NT / 2], int K, const Epi& epi, int astep = 32) {
    const int tid = threadIdx.x, lane = tid & 63, wid = tid >> 6, wr = wid >> 1, wc = wid & 1, fr = lane & 15, fq = lane >> 4;
    constexpr int MT = 4, RH = 64;
    f32x4 acc[NB][MT][NT];
#pragma unroll
    for (int nb = 0; nb < NB; ++nb)
#pragma unroll
        for (int m = 0; m < MT; ++m)
#pragma unroll
            for (int n = 0; n < NT; ++n) acc[nb][m][n] = (f32x4){0.f, 0.f, 0.f, 0.f};
    constexpr int ASZ = 8192, BSZ = NT * 2048, SUBT = ASZ + BSZ * NB, STAGE = 2 * SUBT;
    const int nk = K >> 6;
#define GT8_STAGE(kt_, buf_) do { _Pragma("unroll") for (int su = 0; su < 2; ++su) { \
        _Pragma("unroll") for (int i = 0; i < 2; ++i) \
            __builtin_amdgcn_global_load_lds((const unsigned*)(Ar[i] + ((kt_) * 2 + su) * astep), (LAS unsigned*)(lds + (buf_) * STAGE + su * SUBT + tid * 16 + i * 4096), 16, 0, 0); \
        _Pragma("unroll") for (int i = 0; i < NT / 2; ++i) _Pragma("unroll") for (int nb = 0; nb < NB; ++nb) \
            __builtin_amdgcn_global_load_lds((const unsigned*)(Br[nb][i] + ((kt_) * 2 + su) * 32), (LAS unsigned*)(lds + (buf_) * STAGE + su * SUBT + ASZ + BSZ * nb + tid * 16 + i * 4096), 16, 0, 0); } } while (0)
    GT8_STAGE(0, 0);
#pragma unroll 1
    for (int kt = 0; kt < nk; ++kt) {
        const int cur = kt & 1;
        asm volatile("s_waitcnt vmcnt(0)" ::: "memory");
        __syncthreads();
        if (kt + 1 < nk) GT8_STAGE(kt + 1, cur ^ 1);
        const unsigned char* s0 = lds + cur * STAGE; const unsigned char* s1 = s0 + SUBT;
        i32x8 af[MT], bfr[NB][NT];
#pragma unroll
        for (int m = 0; m < MT; ++m) {
            const int off = AFRAG ? ((wr * MT + m) * 1024 + lane * 16) : (((wr * RH + m * 16 + fr) * 32 + fq * 8) * 2);
            af[m] = cat32(*(const bf16x8*)(s0 + off), *(const bf16x8*)(s1 + off));
        }
#pragma unroll
        for (int nb = 0; nb < NB; ++nb)
#pragma unroll
            for (int n = 0; n < NT; ++n) {
                const int off = ASZ + BSZ * nb + ((wc * (16 * NT) + n * 16 + fr) * 32 + fq * 8) * 2;
                bfr[nb][n] = cat32(*(const bf16x8*)(s0 + off), *(const bf16x8*)(s1 + off));
            }
#pragma unroll
        for (int nb = 0; nb < NB; ++nb)
#pragma unroll
            for (int m = 0; m < MT; ++m)
#pragma unroll
                for (int n = 0; n < NT; ++n)
                    acc[nb][m][n] = __builtin_amdgcn_mfma_scale_f32_16x16x128_f8f6f4(bfr[nb][n], af[m], acc[nb][m][n], 0, 0, 0, 0x7F7F7F7F, 0, 0x7F7F7F7F);
    }
#undef GT8_STAGE
#pragma unroll
    for (int m = 0; m < MT; ++m) {
        const int rl = wr * RH + m * 16 + fr;
        const float rs = epi.rowscale(rl);
#pragma unroll
        for (int q = 0; q < NT / 2; ++q) {
            const int cl = wc * (16 * NT) + q * 32 + 8 * fq;
            if constexpr (NB == 2) (void)epi.store8x2(rl, cl, acc[0][m][2 * q], acc[0][m][2 * q + 1], acc[1][m][2 * q], acc[1][m][2 * q + 1], rs);
            else (void)epi.store8(rl, cl, acc[0][m][2 * q], acc[0][m][2 * q + 1], rs, (f32x4){0.f, 0.f, 0.f, 0.f}, (f32x4){0.f, 0.f, 0.f, 0.f});
        }
        asm volatile("" ::: "memory");
    }
}
DEV int perm_row64(int r) { const int n = (r >> 4) & 1, i = r & 15; return (r & 32) + 8 * (i >> 2) + 4 * n + (i & 3); }

DEV int perm_row(int r) { const int n = (r >> 4) & 3, i = r & 15; return (r & 64) + (n >> 1) * 32 + 8 * (i >> 2) + 4 * (n & 1) + (i & 3); }
DEV u32x4 pk8(f32x4 a, f32x4 b) { u32x4 r; r.x = pk2(a[0], a[1]); r.y = pk2(a[2], a[3]); r.z = pk2(b[0], b[1]); r.w = pk2(b[2], b[3]); return r; }
struct EpiRowBf16 {
    static constexpr bool SYNC_EPI = false;
    bf16_t* out; int ld; const float* rscale; const float* ss16; float mul; int act; int row0; int col0; int lay;
    DEV float rowscale(int rl) const {
        const int row = row0 + rl;
        if (ss16) { const f32x4* s = (const f32x4*)(ss16 + (size_t)row * 16); f32x4 a = s[0], b = s[1], c = s[2], d = s[3];
                    const float t = ((a[0] + a[1]) + (a[2] + a[3])) + ((b[0] + b[1]) + (b[2] + b[3])) + ((c[0] + c[1]) + (c[2] + c[3])) + ((d[0] + d[1]) + (d[2] + d[3]));
                    return rsqrtf(t * (1.f / D) + EPS) * mul; }
        return (rscale ? rscale[row] : 1.f) * mul;
    }
    DEV f32x4 pre(int, int) const { return (f32x4){0.f, 0.f, 0.f, 0.f}; }
    DEV float store8(int rl, int cl, f32x4 v0, f32x4 v1, float rs, f32x4, f32x4) const {
        v0 = v0 * rs; v1 = v1 * rs;
        if (act == 1) {
#pragma unroll
            for (int i = 0; i < 4; ++i) { v0[i] = sigmoidf_(v0[i]); v1[i] = sigmoidf_(v1[i]); }
        }
        const int row = row0 + rl, col = col0 + cl;
        const size_t off = (lay == 0) ? ((size_t)row * ld + col) : frag16_off(row, col, ld >> 5);
        *(u32x4*)(out + off) = pk8(v0, v1);
        return 0.f;
    }
    DEV void rowend(int, int, float) const {}
};
struct EpiGates {
    static constexpr bool SYNC_EPI = false;
    float* G; const float* rscale; const float* bg; int row0;
    DEV float rowscale(int rl) const { return rscale[row0 + rl]; }
    DEV f32x4 pre(int, int) const { return (f32x4){0.f, 0.f, 0.f, 0.f}; }
    DEV float store8(int rl, int cl, f32x4 v0, f32x4 v1, float rs, f32x4, f32x4) const {
        if (cl == 0) {
            v0 = v0 * rs + *(const f32x4*)bg; v1 = v1 * rs + *(const f32x4*)(bg + 4);
#pragma unroll
            for (int i = 0; i < 4; ++i) { const float f = v1[i]; v1[i] = fminf(f, 0.f) - log1pf(__expf(-fabsf(f))); }
            *(f32x4*)(G + (size_t)(row0 + rl) * 8) = v0; *(f32x4*)(G + (size_t)(row0 + rl) * 8 + 4) = v1;
        }
        return 0.f;
    }
    DEV void rowend(int, int, float) const {}
};
struct EpiTrans {
    static constexpr bool SYNC_EPI = false;
    bf16_t* out; const float* rscale; int row0; int col0; int hs; int nh; int sshift;
    DEV f32x4 rowscale4(int rl) const { return *(const f32x4*)(rscale + row0 + rl); }
    DEV void storeT(int rl, int cl, f32x4 v) const {
        const int row = row0 + rl, col = col0 + cl;
        const int b = row >> sshift, s = row & ((1 << sshift) - 1), hh = col >> hs, d = col & ((1 << hs) - 1);
        *(u32x2*)(out + fragp_off(((b * nh + hh) << hs) + d, s, (1 << sshift) >> 5)) = pk4(v);
    }
};
struct EpiResid {
    static constexpr bool SYNC_EPI = false;
    const float* resf; const bf16_t* resb; bf16_t* XB; float* SS; const float* attss; unsigned char* X8; int row0; int col0; int ct;
    DEV float rowscale(int) const { return 1.f; }
    DEV float midscale(int rl) const { const float* a = attss + (size_t)(row0 + rl) * 2; return rsqrtf((a[0] + a[1]) * (1.f / 512.f) + EPS); }
    DEV f32x4 pre(int rl, int cl) const {
        const size_t off = (size_t)(row0 + rl) * D + col0 + cl;
        if (resf) return *(const f32x4*)(resf + off);
        const u32x2 w = *(const u32x2*)(resb + off);
        f32x4 r; r[0] = bflo(w.x); r[1] = bfhi(w.x); r[2] = bflo(w.y); r[3] = bfhi(w.y); return r;
    }
    DEV float store8(int rl, int cl, f32x4 v0, f32x4 v1, float, f32x4 r0, f32x4 r1) const {
        const size_t off = (size_t)(row0 + rl) * D + col0 + cl;
        v0 = v0 + r0; v1 = v1 + r1;
        const u32x4 w = pk8(v0, v1);
        *(u32x4*)(XB + off) = w;
        if (X8) { u32x2 q; q.x = pk4_f8(v0[0], v0[1], v0[2], v0[3]); q.y = pk4_f8(v1[0], v1[1], v1[2], v1[3]); *(u32x2*)(X8 + off) = q; }
        const float a0 = bflo(w.x), a1 = bfhi(w.x), a2 = bflo(w.y), a3 = bfhi(w.y), a4 = bflo(w.z), a5 = bfhi(w.z), a6 = bflo(w.w), a7 = bfhi(w.w);
        return ((a0 * a0 + a1 * a1) + (a2 * a2 + a3 * a3)) + ((a4 * a4 + a5 * a5) + (a6 * a6 + a7 * a7));
    }
    DEV void rowend(int rl, int wc, float ss) const {
        if (SS) { ss += __shfl_xor(ss, 16); ss += __shfl_xor(ss, 32); if ((threadIdx.x & 48) == 0) SS[(size_t)(row0 + rl) * 16 + ct * 2 + wc] = ss; }
    }
};
struct EpiQLds {
    static constexpr bool SYNC_EPI = true;
    unsigned char* q; const float* ss16; float mul; int row0;
    DEV float rowscale(int rl) const {
        const f32x4* s = (const f32x4*)(ss16 + (size_t)(row0 + rl) * 16); f32x4 a = s[0], b = s[1], c = s[2], d = s[3];
        const float t = ((a[0] + a[1]) + (a[2] + a[3])) + ((b[0] + b[1]) + (b[2] + b[3])) + ((c[0] + c[1]) + (c[2] + c[3])) + ((d[0] + d[1]) + (d[2] + d[3]));
        return rsqrtf(t * (1.f / D) + EPS) * mul;
    }
    DEV f32x4 pre(int, int) const { return (f32x4){0.f, 0.f, 0.f, 0.f}; }
    DEV float store8(int rl, int cl, f32x4 v0, f32x4 v1, float rs, f32x4, f32x4) const { *(u32x4*)(q + rl * 272 + cl * 2) = pk8(v0 * rs, v1 * rs); return 0.f; }
    DEV void rowend(int, int, float) const {}
};
struct EpiMoeUp {
    static constexpr bool SYNC_EPI = false;
    unsigned char* HB; const float* rstd2; const int* list; int nvalid; int slot0; int col0;
    DEV float rowscale(int rl) const { const int tok = (rl < nvalid) ? (list[rl] >> 1) : 0; return rstd2[tok] * (1.f / F8_WSCALE); }
    DEV f32x4 pre(int, int) const { return (f32x4){0.f, 0.f, 0.f, 0.f}; }
    DEV float store8x2(int rl, int cl, f32x4 g0, f32x4 g1, f32x4 u0, f32x4 u1, float rs) const {
        f32x4 h0, h1;
#pragma unroll
        for (int i = 0; i < 4; ++i) { h0[i] = siluf_(g0[i] * rs) * (u0[i] * rs) * F8_HSCALE; h1[i] = siluf_(g1[i] * rs) * (u1[i] * rs) * F8_HSCALE; }
        const int row = slot0 + rl, col = col0 + cl;
        u32x2 q; q.x = pk4_f8(h0[0], h0[1], h0[2], h0[3]); q.y = pk4_f8(h1[0], h1[1], h1[2], h1[3]);
        *(u32x2*)(HB + ((size_t)((row >> 4) * 8 + (col >> 6)) * 1024 + ((col >> 4) & 3) * 256 + (row & 15) * 16 + (col & 15))) = q;
        return 0.f;
    }
    DEV float store8(int, int, f32x4, f32x4, float, f32x4, f32x4) const { return 0.f; }
    DEV void rowend(int, int, float) const {}
};
struct EpiMoeDown {
    static constexpr bool SYNC_EPI = false;
    unsigned char* Y; const float* gates; const int* list; int nvalid; int slot0; int col0;
    DEV float rowscale(int rl) const { return (rl < nvalid) ? gates[list[rl]] * (F8_HSCALE / (F8_WSCALE * F8_HSCALE)) : 0.f; }
    DEV f32x4 pre(int, int) const { return (f32x4){0.f, 0.f, 0.f, 0.f}; }
    DEV float store8(int rl, int cl, f32x4 v0, f32x4 v1, float rs, f32x4, f32x4) const {
        v0 = v0 * rs; v1 = v1 * rs;
        u32x2 q; q.x = pk4_f8(v0[0], v0[1], v0[2], v0[3]); q.y = pk4_f8(v1[0], v1[1], v1[2], v1[3]);
        *(u32x2*)(Y + (size_t)(slot0 + rl) * D + col0 + cl) = q;
        return 0.f;
    }
    DEV void rowend(int, int, float) const {}
};

struct Ctx {
    const Params* p; unsigned char* ws; unsigned char* lds;
    int tid, lane, wave, vb, G;
};
#define WSP(T, off) ((T*)(c.ws + (off)))

template <bool HAS_GAIN>
DEV void transpose_item_t(const float* W, int K, int N, int nblk, bf16_t* WT, const float* gain, float* scr, int item, int lane) {
    const int kb = item / nblk, nb = item - kb * nblk, k0 = 64 * kb, n0 = 32 * nb;
    const int n = n0 + (lane & 31), nc = (n < N) ? n : (N - 1);
    const float* src = W + (size_t)(k0 + (lane >> 5)) * N + nc;
    float v[32];
#pragma unroll
    for (int i = 0; i < 32; ++i) v[i] = __builtin_nontemporal_load(src + (size_t)(2 * i) * N);
    if (HAS_GAIN) {
#pragma unroll
        for (int i = 0; i < 32; ++i) v[i] *= gain[k0 + 2 * i + (lane >> 5)];
    }
#pragma unroll
    for (int i = 0; i < 32; ++i) scr[(2 * i + (lane >> 5)) * 33 + (lane & 31)] = (n < N) ? v[i] : 0.f;
    LDS_FENCE();
    const int cc = lane & 7;
#pragma unroll
    for (int j = 0; j < 4; ++j) {
        const int nn = (lane >> 3) + 8 * j; const float* s = scr + (8 * cc) * 33 + nn;
        u32x4 o; o.x = pk2(s[0 * 33], s[1 * 33]); o.y = pk2(s[2 * 33], s[3 * 33]); o.z = pk2(s[4 * 33], s[5 * 33]); o.w = pk2(s[6 * 33], s[7 * 33]);
        *(u32x4*)(WT + (size_t)(n0 + nn) * K + k0 + 8 * cc) = o;
    }
    LDS_FENCE();
}
DEV void transpose_item(const float* W, int K, int N, int nblk, bf16_t* WT, const float* gain, float* scr, int item, int lane) {
    if (gain) transpose_item_t<true>(W, K, N, nblk, WT, gain, scr, item, lane);
    else transpose_item_t<false>(W, K, N, nblk, WT, gain, scr, item, lane);
}
template <bool HAS_GAIN>
DEV void transpose_item_f8(const float* W, int K, int N, int nblk, unsigned char* WT, const float* gain, float* scr, int item, int lane) {
    const int kb = item / nblk, nb = item - kb * nblk, k0 = 64 * kb, n0 = 32 * nb;
    const float* src = W + (size_t)(k0 + (lane >> 5)) * N + n0 + (lane & 31);
    float v[32];
#pragma unroll
    for (int i = 0; i < 32; ++i) v[i] = __builtin_nontemporal_load(src + (size_t)(2 * i) * N);
#pragma unroll
    for (int i = 0; i < 32; ++i) scr[(2 * i + (lane >> 5)) * 33 + (lane & 31)] = v[i] * (HAS_GAIN ? gain[k0 + 2 * i + (lane >> 5)] * F8_WSCALE : F8_WSCALE);
    LDS_FENCE();
    const int cc = lane & 7;
#pragma unroll
    for (int j = 0; j < 4; ++j) {
        const int nn = (lane >> 3) + 8 * j; const float* s = scr + (8 * cc) * 33 + nn;
        u32x2 o; o.x = pk4_f8(s[0 * 33], s[1 * 33], s[2 * 33], s[3 * 33]); o.y = pk4_f8(s[4 * 33], s[5 * 33], s[6 * 33], s[7 * 33]);
        __builtin_nontemporal_store(o, (u32x2*)(WT + (size_t)(n0 + nn) * K + k0 + 8 * cc));
    }
    LDS_FENCE();
}
DEV void row_to_bf16(const float* xrow, bf16_t* orow, float* rstd_out, int lane) {
    const f32x4* xr = (const f32x4*)xrow + lane;
    f32x4 v[2][4];
#pragma unroll
    for (int r = 0; r < 2; ++r)
#pragma unroll
        for (int j = 0; j < 4; ++j) v[r][j] = __builtin_nontemporal_load(xr + r * (D / 4) + 64 * j);
#pragma unroll
    for (int r = 0; r < 2; ++r) {
        float s = 0.f;
#pragma unroll
        for (int j = 0; j < 4; ++j) s += (v[r][j][0] * v[r][j][0] + v[r][j][1] * v[r][j][1]) + (v[r][j][2] * v[r][j][2] + v[r][j][3] * v[r][j][3]);
        s = wave_sum(s);
        u32x2* o8 = (u32x2*)(orow + (size_t)r * D) + lane;
#pragma unroll
        for (int j = 0; j < 4; ++j) o8[64 * j] = pk4(v[r][j]);
        if (lane == 0) rstd_out[r] = rsqrtf(s * (1.f / D) + EPS);
    }
}

DEV void phase_prologue(const Ctx& c) {
    const Params& p = *c.p;
    float* scr = (float*)(c.lds + c.wave * 8704);
    const int gw = c.vb * 4 + c.wave, NGW = c.G * 4;
    constexpr int I_IN = 16 * 92, I_OUT = 16 * 32, I_CQ = 16 * 16, I_CKV = 16 * 32, I_CO = 8 * 32;
    constexpr int NITEMS = I_IN + I_OUT + I_CQ + I_CKV + I_CO;
    for (int it = gw; it < NITEMS; it += NGW) {
        int r = it;
        if (r < I_IN) { transpose_item(p.in[I_W_IN], D, IN_COLS, 92, WSP(bf16_t, WS_WINT), p.in[I_NORM_MIX], scr, r, c.lane); continue; } r -= I_IN;
        if (r < I_OUT) { transpose_item(p.in[I_W_OUT], D, D, 32, WSP(bf16_t, WS_WOUTT), (r < 8 * 32) ? p.in[I_NORM_ATT] : nullptr, scr, r, c.lane); continue; } r -= I_OUT;
        if (r < I_CQ) { transpose_item(p.in[I_W_CQ], D, 512, 16, WSP(bf16_t, WS_WCQT), p.in[I_NORM_CROSS], scr, r, c.lane); continue; } r -= I_CQ;
        if (r < I_CKV) { transpose_item(p.in[I_W_CKV], D, D, 32, WSP(bf16_t, WS_WCKVT), p.in[I_NORM_MEM], scr, r, c.lane); continue; } r -= I_CKV;
        transpose_item(p.in[I_W_CO], 512, D, 32, WSP(bf16_t, WS_WCOT), nullptr, scr, r, c.lane);
    }
    for (int m2 = gw; m2 < (M + MEMROWS) / 2; m2 += NGW) {
        const int m = m2 * 2;
        if (m < M) row_to_bf16(p.in[I_X] + (size_t)m * D, WSP(bf16_t, WS_XB) + (size_t)m * D, WSP(float, WS_RSTD0) + m, c.lane);
        else { const int r = m - M; row_to_bf16(p.in[I_MEM] + (size_t)r * D, WSP(bf16_t, WS_MEMB) + (size_t)r * D, WSP(float, WS_RSTDM) + r, c.lane); }
    }
    for (int e = c.vb * 256 + c.tid; e < 48 * D; e += c.G * 256) {
        const int ci = e >> 10, k = e & 1023;
        float w = 0.f;
        if (ci < 36) w = ((ci < 4) ? p.in[I_W_RG][k * 4 + ci] : p.in[I_W_RE][k * 32 + (ci - 4)]) * p.in[I_NORM_FFN][k];
        const unsigned hi = f2bf(w);
        const size_t fo = frag16_off(ci, k, 32);
        WSP(bf16_t, WS_WRH)[fo] = (bf16_t)hi; WSP(bf16_t, WS_WRL)[fo] = (bf16_t)f2bf(w - bf2f(hi));
    }
}

constexpr int CONV_TOTAL = NEXP * 768, CONV_QUOTA = 2;
DEV void expert_convert_round(const Ctx& c, int round) {
    const Params& p = *c.p;
    float* scr = (float*)(c.lds + c.wave * 8704);
    const int it = round * (c.G * 4) + c.vb * 4 + c.wave;
    if (it < CONV_TOTAL) {
        const int e = it / 768; int r = it - e * 768;
        if (r < 256) transpose_item_f8<true>(p.in[I_W_EG] + (size_t)e * D * DEXP, D, DEXP, 16, WSP(unsigned char, WS_WGT) + (size_t)e * DEXP * D, p.in[I_NORM_FFN], scr, r, c.lane);
        else if (r < 512) transpose_item_f8<true>(p.in[I_W_EU] + (size_t)e * D * DEXP, D, DEXP, 16, WSP(unsigned char, WS_WUT) + (size_t)e * DEXP * D, p.in[I_NORM_FFN], scr, r - 256, c.lane);
        else transpose_item_f8<false>(p.in[I_W_ED] + (size_t)e * DEXP * D, DEXP, D, 32, WSP(unsigned char, WS_WDT) + (size_t)e * D * DEXP, nullptr, scr, r - 512, c.lane);
    }
}
DEV void expert_convert_rest(const Ctx& c, int& conv_done) {
    while (conv_done * (c.G * 4) < CONV_TOTAL) { expert_convert_round(c, conv_done); ++conv_done; }
    __syncthreads();
}
DEV void xcd_barrier_work(const XcdBarrier& b, const Ctx& c, int& conv_done, int quota) {
    asm volatile("s_waitcnt vmcnt(0)" ::: "memory");
    __syncthreads();
    if (threadIdx.x == 0) {
        unsigned* bar = b.bar;
        __builtin_amdgcn_s_waitcnt(0);
        unsigned nloc = b.st[0], nx = b.st[1];
        if (nloc == 0u) { xcd_barrier_complete(bar, b.x, nloc, nx); b.st[0] = nloc; b.st[1] = nx; }
        const unsigned old = xb_add(&bar[XB_XSUB(b.x)], 1u);
        const unsigned gen = old / nloc;
        b.st[2] = (old + 1u == (gen + 1u) * nloc) ? 1u : 0u;
        b.st[3] = gen;
    }
    __syncthreads();
    const bool leader = b.st[2] != 0u;
    if (!leader) { for (int q = 0; q < quota && conv_done * (c.G * 4) < CONV_TOTAL; ++q) { expert_convert_round(c, conv_done); ++conv_done; } }
    if (threadIdx.x == 0) {
        unsigned* bar = b.bar;
        const unsigned nx = b.st[1], gen = b.st[3];
        if (leader) {
            __builtin_amdgcn_fence(__ATOMIC_RELEASE, "agent");
            asm volatile("s_waitcnt vmcnt(0)" ::: "memory");
            const unsigned og = xb_add(&bar[XB_TOP], 1u);
            const unsigned tg = og / nx;
            if (og + 1u == (tg + 1u) * nx) xb_add(&bar[XB_TOPGEN], 1u);
            else XB_SPIN(xb_ld(&bar[XB_TOPGEN]) == tg, bar);
            __builtin_amdgcn_fence(__ATOMIC_ACQUIRE, "agent");
            xb_add(&bar[XB_XGEN(b.x)], 1u);
            asm volatile("s_waitcnt vmcnt(0)" ::: "memory");
        } else {
            XB_SPIN(xb_ld(&bar[XB_XGEN(b.x)]) == gen, bar);
            __builtin_amdgcn_fence(__ATOMIC_ACQUIRE, "agent");
            asm volatile("s_waitcnt vmcnt(0)" ::: "memory");
        }
    }
    __syncthreads();
}

DEV void phase_inproj(const Ctx& c) {
    const Params& p = *c.p;
    const int tid = c.tid, sr = tid >> 2, sc = (tid & 3) * 8;
    constexpr int NT_MAIN = 64 * 23, NT = NT_MAIN + 32;
    for (int id = c.vb; id < NT; id += c.G) {
        int rb, ct, kind;
        const bf16_t* A; const bf16_t* Bt; const float* rs; bf16_t* out; int ld = 0, lay = 0, act = 0, col0 = 0, hs = 7, nh = 4, sshift = 12; float mul = 1.f;
        if (id < NT_MAIN) {
            const int grp = id / (4 * 23), rem = id - grp * (4 * 23); ct = rem >> 2; rb = grp * 4 + (rem & 3);
            A = WSP(bf16_t, WS_XB); Bt = WSP(bf16_t, WS_WINT); rs = WSP(float, WS_RSTD0);
            if (ct < 4)        { kind = 0; out = WSP(bf16_t, WS_QA); ld = 512; lay = 1; mul = 0.125f; col0 = ct * 128; }
            else if (ct == 4)  { kind = 0; out = WSP(bf16_t, WS_KA); ld = 128; lay = 1; }
            else if (ct == 5)  { kind = 1; out = WSP(bf16_t, WS_VAT); hs = 6; nh = 2; }
            else if (ct < 14)  { kind = 0; out = WSP(bf16_t, WS_QKR); ld = 1024; col0 = (ct - 6) * 128; }
            else if (ct < 18)  { kind = 1; out = WSP(bf16_t, WS_VMT); col0 = (ct - 14) * 128; }
            else if (ct < 22)  { kind = 0; out = WSP(bf16_t, WS_OM); ld = 512; lay = 1; act = 1; col0 = (ct - 18) * 128; }
            else               { kind = 2; out = nullptr; }
        } else {
            const int k = id - NT_MAIN; rb = k >> 3; ct = k & 7;
            A = WSP(bf16_t, WS_MEMB); Bt = WSP(bf16_t, WS_WCKVT); rs = WSP(float, WS_RSTDM);
            if (ct < 4) { kind = 0; out = WSP(bf16_t, WS_KMEM); ld = 512; lay = 1; col0 = ct * 128; }
            else        { kind = 1; out = WSP(bf16_t, WS_VMEMT); col0 = (ct - 4) * 128; sshift = 8; }
        }
        const int row0 = rb * 256;
        const bf16_t* A0 = A + (size_t)(row0 + sr) * D + sc;
        const bf16_t* Ar[4] = { A0, A0 + (size_t)64 * D, A0 + (size_t)128 * D, A0 + (size_t)192 * D };
        const int br0 = (kind == 1) ? sr : perm_row(sr);
        const bf16_t* Br[1][2] = { { Bt + (size_t)(ct * 128 + br0) * D + sc, Bt + (size_t)(ct * 128 + br0 + 64) * D + sc } };
        if (kind == 0)      { EpiRowBf16 e{out, ld, rs, nullptr, mul, act, row0, col0, lay}; gemm_tile<1, 8, false>(c.lds, Ar, Br, D, e); }
        else if (kind == 1) { EpiTrans e{out, rs, row0, col0, hs, nh, sshift}; gemm_tile<1, 8, true>(c.lds, Ar, Br, D, e); }
        else                { EpiGates e{WSP(float, WS_G), rs, p.in[I_B_GATES], row0}; gemm_tile<1, 8, false>(c.lds, Ar, Br, D, e); }
    }
}

DEV void attn_item(const Ctx& c, int item) {
    const Params& p = *c.p;
    const int lane = c.lane, fr = lane & 15, fq = lane >> 4;
    const int b = item >> 9, qb = (item >> 1) & 255, kvh = item & 1, q0 = qb * 16, tok0 = b * SEQ + q0, kbase = (q0 - 128) & ~31;
    const bf16_t* QA = WSP(bf16_t, WS_QA); const bf16_t* KA = WSP(bf16_t, WS_KA); const bf16_t* VAT = WSP(bf16_t, WS_VAT);
    bf16_t* MIX = WSP(bf16_t, WS_MIX);
    float ssq = 0.f;
    const int t = q0 + fr;
#pragma unroll 1
    for (int g = 0; g < 4; ++g) {
        const int h = kvh * 4 + g;
        bf16x8 kf[10][2];
#pragma unroll
        for (int kt = 0; kt < 10; ++kt) {
            int ktile = (kbase >> 4) + kt; ktile = ktile < 0 ? 0 : (ktile > 255 ? 255 : ktile);
#pragma unroll
            for (int ks = 0; ks < 2; ++ks) kf[kt][ks] = *frag_ptr(KA, b * 256 + ktile, kvh * 2 + ks, 4, lane);
        }
        const float slope = exp2f(-(float)(h + 1)), sink = p.in[I_SINKS][h];
        const bf16x8 qf0 = __builtin_nontemporal_load(frag_ptr(QA, tok0 >> 4, h * 2, 16, lane)), qf1 = __builtin_nontemporal_load(frag_ptr(QA, tok0 >> 4, h * 2 + 1, 16, lane));
        __builtin_amdgcn_sched_barrier(0);
        f32x4 s[10];
#pragma unroll
        for (int kt = 0; kt < 10; ++kt) {
            f32x4 acc = {0.f, 0.f, 0.f, 0.f};
            acc = mfma16(kf[kt][0], qf0, acc); acc = mfma16(kf[kt][1], qf1, acc);
            s[kt] = acc;
        }
        float mx = sink;
#pragma unroll
        for (int kt = 0; kt < 10; ++kt)
#pragma unroll
            for (int r = 0; r < 4; ++r) {
                const int key = kbase + kt * 16 + 4 * fq + r, dist = t - key;
                const bool valid = (key >= 0) && (dist >= 0) && (dist < 128);
                const float l = valid ? s[kt][r] - slope * (float)dist : -INFINITY;
                s[kt][r] = l; mx = fmaxf(mx, l);
            }
        mx = fmaxf(mx, __shfl_xor(mx, 16)); mx = fmaxf(mx, __shfl_xor(mx, 32));
        float sum = 0.f;
#pragma unroll
        for (int kt = 0; kt < 10; ++kt)
#pragma unroll
            for (int r = 0; r < 4; ++r) { const float e = __expf(s[kt][r] - mx); s[kt][r] = e; sum += e; }
        sum += __shfl_xor(sum, 16); sum += __shfl_xor(sum, 32);
        const float inv = 1.f / (sum + __expf(sink - mx));
        bf16x8 pf[5];
#pragma unroll
        for (int i = 0; i < 5; ++i) pf[i] = frag_from(pk4(s[2 * i] * inv), pk4(s[2 * i + 1] * inv));
#pragma unroll
        for (int dg = 0; dg < 2; ++dg) {
            bf16x8 vf[2][5];
#pragma unroll
            for (int u = 0; u < 2; ++u)
#pragma unroll
                for (int i = 0; i < 5; ++i) { int i32 = (kbase >> 5) + i; i32 = i32 < 0 ? 0 : (i32 > 127 ? 127 : i32); vf[u][i] = *frag_ptr(VAT, (b * 2 + kvh) * 4 + dg * 2 + u, i32, 128, lane); }
            __builtin_amdgcn_sched_barrier(0);
#pragma unroll
            for (int u = 0; u < 2; ++u) {
                const int dt = dg * 2 + u;
                f32x4 acc = {0.f, 0.f, 0.f, 0.f};
#pragma unroll
                for (int i = 0; i < 5; ++i) acc = mfma16(vf[u][i], pf[i], acc);
                const u32x2 w = pk4(acc);
                *(u32x2*)(MIX + frag16_off(tok0 + fr, h * 64 + dt * 16 + 4 * fq, 32)) = w;
                const float a0 = bflo(w.x), a1 = bfhi(w.x), a2 = bflo(w.y), a3 = bfhi(w.y);
                ssq += (a0 * a0 + a1 * a1) + (a2 * a2 + a3 * a3);
            }
        }
    }
    ssq += __shfl_xor(ssq, 16); ssq += __shfl_xor(ssq, 32);
    if (fq == 0) WSP(float, WS_ATTSS)[(size_t)(tok0 + fr) * 2 + kvh] = ssq;
}

DEV void conv4x8(const bf16_t* raw, int seq_pos0, const float* cw, const float* cbias, int chn0, float (&out)[4][8]) {
    u32x4 rv[7];
#pragma unroll
    for (int i = 0; i < 7; ++i) {
        const bool ok = (seq_pos0 + i - 3) >= 0;
        rv[i] = *(const u32x4*)(raw + (ok ? (i - 3) : 0) * 1024);
        if (!ok) rv[i] = (u32x4){0u, 0u, 0u, 0u};
    }
    f32x4 w[4][2];
#pragma unroll
    for (int t = 0; t < 4; ++t) { w[t][0] = *(const f32x4*)(cw + t * 1024 + chn0); w[t][1] = *(const f32x4*)(cw + t * 1024 + chn0 + 4); }
    const f32x4 b0 = *(const f32x4*)(cbias + chn0), b1 = *(const f32x4*)(cbias + chn0 + 4);
    float x[7][8];
#pragma unroll
    for (int i = 0; i < 7; ++i)
#pragma unroll
        for (int j = 0; j < 4; ++j) { x[i][2 * j] = bflo(rv[i][j]); x[i][2 * j + 1] = bfhi(rv[i][j]); }
#pragma unroll
    for (int r = 0; r < 4; ++r)
#pragma unroll
        for (int j = 0; j < 8; ++j) {
            float o = (j < 4) ? b0[j & 3] : b1[j & 3];
#pragma unroll
            for (int t = 0; t < 4; ++t) o += ((j < 4) ? w[t][0][j & 3] : w[t][1][j & 3]) * x[r + t][j];
            out[r][j] = siluf_(o);
        }
}
DEV void mlstm_a_item(const Ctx& c, int item) {
    const Params& p = *c.p;
    const int tid = c.tid, lane = c.lane, wave = c.wave, fr = lane & 15, fq = lane >> 4;
    const int bh = item >> 6, ch = item & 63, b = bh >> 2, h = bh & 3, tokc = b * SEQ + ch * 64;
    bf16_t* KwT = (bf16_t*)c.lds;
    float* wsc = (float*)(c.lds + 18432);
    float* unp = (float*)(c.lds + 18432 + 256);
    const float* G = WSP(float, WS_G);
    float ig = 0.f, lf = 0.f;
    if (wave == 0) { ig = G[(size_t)(tokc + lane) * 8 + h]; lf = G[(size_t)(tokc + lane) * 8 + 4 + h]; }
    const int cg = tid & 15, rg = tid >> 4, s0 = 4 * rg, chn0 = 512 + h * 128 + 8 * cg;
    float kv[4][8];
    conv4x8(WSP(bf16_t, WS_QKR) + (size_t)(tokc + s0) * 1024 + chn0, ch * 64 + s0, p.in[I_CONV_W], p.in[I_CONV_B], chn0, kv);
    if (wave == 0) {
        float bcs = lf;
#pragma unroll
        for (int o = 1; o < 64; o <<= 1) { const float u = __shfl_up(bcs, o); if (lane >= o) bcs += u; }
        const float blast = __shfl(bcs, 63);
        const float logw = blast - bcs + ig;
        const float mloc = wave_max(logw);
        wsc[lane] = __expf(logw - mloc);
        if (lane == 0) { float* sc = WSP(float, WS_SC) + (size_t)item * 2; sc[0] = blast; sc[1] = mloc; }
    }
    __syncthreads();
    {
        const float w0 = wsc[s0] * 0.08838834764831845f, w1 = wsc[s0 + 1] * 0.08838834764831845f, w2 = wsc[s0 + 2] * 0.08838834764831845f, w3 = wsc[s0 + 3] * 0.08838834764831845f;
#pragma unroll
        for (int j = 0; j < 8; ++j) {
            f32x4 kw; kw[0] = kv[0][j] * w0; kw[1] = kv[1][j] * w1; kw[2] = kv[2][j] * w2; kw[3] = kv[3][j] * w3;
            *(u32x2*)(KwT + (8 * cg + j) * 72 + s0) = pk4(kw);
            float un = (kw[0] + kw[1]) + (kw[2] + kw[3]);
            un += __shfl_xor(un, 16); un += __shfl_xor(un, 32);
            if (lane < 16) unp[wave * 128 + 8 * cg + j] = un;
        }
    }
    __syncthreads();
    if (tid < 128) WSP(float, WS_UN)[(size_t)item * 128 + tid] = (unp[tid] + unp[128 + tid]) + (unp[256 + tid] + unp[384 + tid]);
    {
        const bf16_t* VMT = WSP(bf16_t, WS_VMT);
        f32x4 acc[2][8];
#pragma unroll
        for (int a = 0; a < 2; ++a)
#pragma unroll
            for (int n = 0; n < 8; ++n) acc[a][n] = (f32x4){0.f, 0.f, 0.f, 0.f};
        bf16x8 vfr[2][2];
#pragma unroll
        for (int ks = 0; ks < 2; ++ks)
#pragma unroll
            for (int a = 0; a < 2; ++a) vfr[ks][a] = *frag_ptr(VMT, bh * 8 + 2 * wave + a, ch * 2 + ks, 128, lane);
#pragma unroll
        for (int ks = 0; ks < 2; ++ks) {
#pragma unroll
            for (int n = 0; n < 8; ++n) {
                const bf16_t* kr = KwT + (n * 16 + fr) * 72 + ks * 32 + 4 * fq;
                const bf16x8 kk = frag_from(*(const u32x2*)kr, *(const u32x2*)(kr + 16));
#pragma unroll
                for (int a = 0; a < 2; ++a) acc[a][n] = mfma16(kk, vfr[ks][a], acc[a][n]);
            }
        }
        bf16_t* UT = ((bf16_t*)c.p->out) + (size_t)item * 16384;
#pragma unroll
        for (int a = 0; a < 2; ++a)
#pragma unroll
            for (int n = 0; n < 8; ++n) *(u32x2*)(UT + frag16_off((2 * wave + a) * 16 + fr, n * 16 + 4 * fq, 4)) = pk4(acc[a][n]);
    }
    __syncthreads();
}

DEV void phase_mix_a(const Ctx& c) {
    const int gw = c.vb * 4 + c.wave, NGW = c.G * 4;
    const bool attn_first = blockIdx.x >= (unsigned)(c.G >> 1);
    if (attn_first) { for (int item = gw; item < 2048; item += NGW) attn_item(c, item); }
    for (int item = c.vb; item < 1024; item += c.G) mlstm_a_item(c, item);
    if (!attn_first) { for (int item = gw; item < 2048; item += NGW) attn_item(c, item); }
}

DEV void phase_mlstm_scan(const Ctx& c) {
    float* dec = (float*)c.lds; float* inj = dec + 64; float* mpv = dec + 128;
    const int tid = c.tid;
    for (int item = c.vb; item < 16 * 17; item += c.G) {
        const int bh = item / 17, sl = item - bh * 17;
        if (c.wave == 0) {
            const float* sc = WSP(float, WS_SC) + (size_t)bh * 64 * 2;
            const int lane = c.lane;
            const float bl = sc[2 * lane], ml = sc[2 * lane + 1];
            float A = ml, B = bl;
#pragma unroll
            for (int o = 1; o < 64; o <<= 1) {
                const float Ap = __shfl_up(A, o), Bp = __shfl_up(B, o);
                if (lane >= o) { A = fmaxf(A, B + Ap); B = B + Bp; }
            }
            const float mcur = fmaxf(A, B + 0.f);
            float mprev = __shfl_up(mcur, 1); if (lane == 0) mprev = 0.f;
            dec[lane] = __expf(bl + mprev - mcur); inj[lane] = __expf(ml - mcur); mpv[lane] = mprev;
        }
        __syncthreads();
        if (sl < 16) {
            const bf16_t* UT = ((const bf16_t*)c.p->out) + (size_t)bh * 64 * 16384 + sl * 1024 + tid * 4;
            bf16_t* CP = ((bf16_t*)c.p->out) + (size_t)1024 * 16384 + (size_t)bh * 64 * 16384 + sl * 1024 + tid * 4;
            f32x4 s = {0.f, 0.f, 0.f, 0.f};
#pragma unroll 16
            for (int k = 0; k < 64; ++k) {
                const u32x2 u = __builtin_nontemporal_load((const u32x2*)(UT + (size_t)k * 16384));
                *(u32x2*)(CP + (size_t)k * 16384) = pk4(s);
                f32x4 uv; uv[0] = bflo(u.x); uv[1] = bfhi(u.x); uv[2] = bflo(u.y); uv[3] = bfhi(u.y);
                s = s * dec[k] + uv * inj[k];
            }
        } else {
            if (tid < 128) {
                const float* UN = WSP(float, WS_UN) + (size_t)bh * 64 * 128 + tid;
                float* NP = WSP(float, WS_NP) + (size_t)bh * 64 * 128 + tid;
                float s0 = 0.f;
#pragma unroll 8
                for (int k = 0; k < 64; ++k) { const float u0 = UN[k * 128]; NP[k * 128] = s0; s0 = dec[k] * s0 + inj[k] * u0; }
            } else if (tid < 192) {
                WSP(float, WS_MP)[bh * 64 + (tid - 128)] = mpv[tid - 128];
            }
        }
        __syncthreads();
    }
}

DEV void mlstm_c_item(const Ctx& c, int item) {
    const Params& p = *c.p;
    const int tid = c.tid, lane = c.lane, wave = c.wave, fr = lane & 15, fq = lane >> 4;
    const int bh = item >> 6, ch = item & 63, b = bh >> 2, h = bh & 3, tokc = b * SEQ + ch * 64;
    bf16_t* Qs = (bf16_t*)c.lds;
    bf16_t* Ks = (bf16_t*)(c.lds + 17408);
    float* a_s = (float*)(c.lds + 34816);
    float* Mt  = a_s + 64;
    float* ain = a_s + 128;
    float* en  = a_s + 192;
    float* npv = a_s + 256;
    const float* G = WSP(float, WS_G);
    float ig = 0.f, lf = 0.f, mprev = 0.f, np0 = 0.f, np1 = 0.f;
    if (wave == 0) { ig = G[(size_t)(tokc + lane) * 8 + h]; lf = G[(size_t)(tokc + lane) * 8 + 4 + h]; mprev = WSP(float, WS_MP)[item]; }
    else if (wave == 1) { const float* NP = WSP(float, WS_NP) + (size_t)item * 128; np0 = NP[lane]; np1 = NP[64 + lane]; }
    {
        const int cg = tid & 15, rg = tid >> 4, s0 = 4 * rg;
        float v[4][8];
        {
            const int chn0 = h * 128 + 8 * cg;
            conv4x8(WSP(bf16_t, WS_QKR) + (size_t)(tokc + s0) * 1024 + chn0, ch * 64 + s0, p.in[I_CONV_W], p.in[I_CONV_B], chn0, v);
#pragma unroll
            for (int r = 0; r < 4; ++r) { u32x4 o; o.x = pk2(v[r][0], v[r][1]); o.y = pk2(v[r][2], v[r][3]); o.z = pk2(v[r][4], v[r][5]); o.w = pk2(v[r][6], v[r][7]);
                                          *(u32x4*)(Qs + (s0 + r) * 136 + 8 * cg) = o; }
        }
        {
            const int chn0 = 512 + h * 128 + 8 * cg; const float sc = 0.08838834764831845f;
            conv4x8(WSP(bf16_t, WS_QKR) + (size_t)(tokc + s0) * 1024 + chn0, ch * 64 + s0, p.in[I_CONV_W], p.in[I_CONV_B], chn0, v);
#pragma unroll
            for (int r = 0; r < 4; ++r) { u32x4 o; o.x = pk2(v[r][0] * sc, v[r][1] * sc); o.y = pk2(v[r][2] * sc, v[r][3] * sc); o.z = pk2(v[r][4] * sc, v[r][5] * sc); o.w = pk2(v[r][6] * sc, v[r][7] * sc);
                                          *(u32x4*)(Ks + (s0 + r) * 136 + 8 * cg) = o; }
        }
    }
    if (wave == 0) {
        float bcs = lf;
#pragma unroll
        for (int o = 1; o < 64; o <<= 1) { const float u = __shfl_up(bcs, o); if (lane >= o) bcs += u; }
        const float a = ig - bcs;
        float pm = a;
#pragma unroll
        for (int o = 1; o < 64; o <<= 1) { const float u = __shfl_up(pm, o); if (lane >= o) pm = fmaxf(pm, u); }
        const float mt = fmaxf(mprev, pm);
        a_s[lane] = a; Mt[lane] = mt; ain[lane] = __expf(mprev - mt); en[lane] = __expf(-(bcs + mt));
    } else if (wave == 1) { npv[lane] = np0; npv[64 + lane] = np1; }
    __syncthreads();
    {
        const int t = wave * 16 + fr;
        bf16x8 qf[4];
#pragma unroll
        for (int ks = 0; ks < 4; ++ks) qf[ks] = *(const bf16x8*)(Qs + t * 136 + ks * 32 + 8 * fq);
        const float mt = Mt[t];
        f32x4 pt[4]; float dl = 0.f;
#pragma unroll
        for (int st = 0; st < 4; ++st) {
            f32x4 acc = {0.f, 0.f, 0.f, 0.f};
            if (st <= wave) {
#pragma unroll
                for (int ks = 0; ks < 4; ++ks) acc = mfma16(*(const bf16x8*)(Ks + (st * 16 + fr) * 136 + ks * 32 + 8 * fq), qf[ks], acc);
#pragma unroll
                for (int r = 0; r < 4; ++r) {
                    const int s = st * 16 + 4 * fq + r;
                    const float v = (s <= t) ? acc[r] * __expf(a_s[s] - mt) : 0.f;
                    const float vr = bflo(pk2(v, 0.f));
                    acc[r] = vr; dl += vr;
                }
            }
            pt[st] = acc;
        }
        dl += __shfl_xor(dl, 16); dl += __shfl_xor(dl, 32);
        float dn = 0.f;
#pragma unroll
        for (int j = 0; j < 32; ++j) dn += bf2f(Qs[t * 136 + 32 * fq + j]) * npv[32 * fq + j];
        dn += __shfl_xor(dn, 16); dn += __shfl_xor(dn, 32);
        const float ai = ain[t];
        const float den = dl + ai * dn;
        const float invd = 1.f / fmaxf(fabsf(den), en[t]);
        bf16x8 pf[2];
#pragma unroll
        for (int i = 0; i < 2; ++i) pf[i] = frag_from(pk4(pt[2 * i]), pk4(pt[2 * i + 1]));
        const bf16_t* VMT = WSP(bf16_t, WS_VMT);
        const bf16_t* CP = ((const bf16_t*)c.p->out) + (size_t)1024 * 16384 + (size_t)item * 16384;
        const bf16_t* OM = WSP(bf16_t, WS_OM);
        f32x4 hv[8]; float ssq = 0.f;
#pragma unroll
        for (int dg = 0; dg < 2; ++dg) {
            bf16x8 vfr[4][2], cfr[4][4]; u32x2 ow[4];
#pragma unroll
            for (int u = 0; u < 4; ++u) {
                const int dvt = dg * 4 + u;
#pragma unroll
                for (int i = 0; i < 2; ++i) vfr[u][i] = __builtin_nontemporal_load(frag_ptr(VMT, bh * 8 + dvt, ch * 2 + i, 128, lane));
#pragma unroll
                for (int ks = 0; ks < 4; ++ks) cfr[u][ks] = __builtin_nontemporal_load(frag_ptr(CP, dvt, ks, 4, lane));
                ow[u] = __builtin_nontemporal_load((const u32x2*)(OM + frag16_off(tokc + wave * 16 + fr, h * 128 + dvt * 16 + 4 * fq, 16)));
            }
            __builtin_amdgcn_sched_barrier(0);
#pragma unroll
            for (int u = 0; u < 4; ++u) {
                f32x4 apv = {0.f, 0.f, 0.f, 0.f}, aqc = {0.f, 0.f, 0.f, 0.f};
#pragma unroll
                for (int i = 0; i < 2; ++i) apv = mfma16(vfr[u][i], pf[i], apv);
#pragma unroll
                for (int ks = 0; ks < 4; ++ks) aqc = mfma16(cfr[u][ks], qf[ks], aqc);
                f32x4 hh = (apv + aqc * ai) * invd;
                hh[0] *= bflo(ow[u].x); hh[1] *= bfhi(ow[u].x); hh[2] *= bflo(ow[u].y); hh[3] *= bfhi(ow[u].y);
                hv[dg * 4 + u] = hh; ssq += (hh[0] * hh[0] + hh[1] * hh[1]) + (hh[2] * hh[2] + hh[3] * hh[3]);
            }
        }
        ssq += __shfl_xor(ssq, 16); ssq += __shfl_xor(ssq, 32);
        const float rstd = rsqrtf(ssq * (1.f / 128.f) + EPS);
        const float* g = p.in[I_NORM_ML] + h * 128;
        bf16_t* MIX = WSP(bf16_t, WS_MIX);
#pragma unroll
        for (int dvt = 0; dvt < 8; ++dvt) {
            const f32x4 gg = *(const f32x4*)(g + dvt * 16 + 4 * fq);
            *(u32x2*)(MIX + frag16_off(tokc + t, 512 + h * 128 + dvt * 16 + 4 * fq, 32)) = pk4(hv[dvt] * rstd * gg);
        }
    }
    __syncthreads();
}
DEV void phase_mlstm_c(const Ctx& c) {
    for (int item = c.vb; item < 1024; item += c.G) mlstm_c_item(c, item);
}

DEV void phase_outproj(const Ctx& c) {
    const Params& p = *c.p; const int tid = c.tid, sr = tid >> 2, sc = (tid & 3) * 8;
    for (int id = c.vb; id < 64 * 8; id += c.G) {
        const int grp = id >> 5, rem = id & 31, ct = rem >> 2, rb = grp * 4 + (rem & 3), row0 = rb * 256;
        const bf16_t* A = WSP(bf16_t, WS_MIX) + (size_t)((row0 >> 4) + (tid >> 6)) * 32 * 512 + (tid & 63) * 8; const bf16_t* Bt = WSP(bf16_t, WS_WOUTT);
        const bf16_t* Ar[4] = { A, A + (size_t)4 * 32 * 512, A + (size_t)8 * 32 * 512, A + (size_t)12 * 32 * 512 };
        const int br0 = perm_row(sr);
        const bf16_t* Br[1][2] = { { Bt + (size_t)(ct * 128 + br0) * D + sc, Bt + (size_t)(ct * 128 + br0 + 64) * D + sc } };
        EpiResid e{nullptr, WSP(bf16_t, WS_XB), WSP(bf16_t, WS_XB), WSP(float, WS_SS1), WSP(float, WS_ATTSS), nullptr, row0, ct * 128, ct};
        gemm_tile<1, 8, false, true, true>(c.lds, Ar, Br, D, e, 16, 512);
    }
}
DEV void cross_item(const Ctx& c, int tt, int h, const unsigned char* qlds) {
    const int lane = c.lane, fr = lane & 15, fq = lane >> 4;
    const int tok0 = tt * 16, b = tok0 >> 12;
    const bf16_t* KM = WSP(bf16_t, WS_KMEM); const bf16_t* VT = WSP(bf16_t, WS_VMEMT);
    bf16x8 qf[4];
#pragma unroll
    for (int ks = 0; ks < 4; ++ks) qf[ks] = *(const bf16x8*)(qlds + fr * 272 + (ks * 32 + 8 * fq) * 2);
    f32x4 s[16];
#pragma unroll
    for (int sg = 0; sg < 4; ++sg) {
        bf16x8 kf[4][4];
#pragma unroll
        for (int u = 0; u < 4; ++u) {
#pragma unroll
            for (int ks = 0; ks < 4; ++ks) kf[u][ks] = *frag_ptr(KM, b * 16 + sg * 4 + u, h * 4 + ks, 16, lane);
        }
        __builtin_amdgcn_sched_barrier(0);
#pragma unroll
        for (int u = 0; u < 4; ++u) {
            f32x4 acc = {0.f, 0.f, 0.f, 0.f};
#pragma unroll
            for (int ks = 0; ks < 4; ++ks) acc = mfma16(kf[u][ks], qf[ks], acc);
            s[sg * 4 + u] = acc;
        }
    }
    float mx = -INFINITY;
#pragma unroll
    for (int st = 0; st < 16; ++st)
#pragma unroll
        for (int r = 0; r < 4; ++r) mx = fmaxf(mx, s[st][r]);
    mx = fmaxf(mx, __shfl_xor(mx, 16)); mx = fmaxf(mx, __shfl_xor(mx, 32));
    float sum = 0.f;
#pragma unroll
    for (int st = 0; st < 16; ++st)
#pragma unroll
        for (int r = 0; r < 4; ++r) { const float e = __expf(s[st][r] - mx); s[st][r] = e; sum += e; }
    sum += __shfl_xor(sum, 16); sum += __shfl_xor(sum, 32);
    const float inv = 1.f / sum;
    bf16x8 pf[8];
#pragma unroll
    for (int i = 0; i < 8; ++i) pf[i] = frag_from(pk4(s[2 * i] * inv), pk4(s[2 * i + 1] * inv));
    bf16_t* O = WSP(bf16_t, WS_O);
#pragma unroll
    for (int dg = 0; dg < 4; ++dg) {
        bf16x8 vfr[2][8];
#pragma unroll
        for (int u = 0; u < 2; ++u)
#pragma unroll
            for (int i = 0; i < 8; ++i) vfr[u][i] = *frag_ptr(VT, (b * 4 + h) * 8 + dg * 2 + u, i, 8, lane);
        __builtin_amdgcn_sched_barrier(0);
#pragma unroll
        for (int u = 0; u < 2; ++u) {
            f32x4 acc = {0.f, 0.f, 0.f, 0.f};
#pragma unroll
            for (int i = 0; i < 8; ++i) acc = mfma16(vfr[u][i], pf[i], acc);
            *(u32x2*)(O + frag16_off(tok0 + fr, h * 128 + (dg * 2 + u) * 16 + 4 * fq, 16)) = pk4(acc);
        }
    }
}
DEV void phase_crossqa(const Ctx& c) {
    const int tid = c.tid, sr = tid >> 2, sc = (tid & 3) * 8;
    for (int id = c.vb; id < 128 * 4; id += c.G) {
        const int grp = id >> 5, rem = id & 31, h = rem >> 3, rb = grp * 8 + (rem & 7), row0 = rb * 128;
        const bf16_t* A = WSP(bf16_t, WS_XB); const bf16_t* Bt = WSP(bf16_t, WS_WCQT);
        const bf16_t* Ar[2] = { A + (size_t)(row0 + sr) * D + sc, A + (size_t)(row0 + sr + 64) * D + sc };
        const int br0 = perm_row(sr);
        const bf16_t* Br[1][2] = { { Bt + (size_t)(h * 128 + br0) * D + sc, Bt + (size_t)(h * 128 + br0 + 64) * D + sc } };
        EpiQLds e{c.lds, WSP(float, WS_SS1), 0.08838834764831845f, row0};
        gemm_tile<1, 4, false>(c.lds, Ar, Br, D, e);
        __syncthreads();
#pragma unroll 1
        for (int u = 0; u < 2; ++u) {
            int hh = h; asm volatile("" : "+s"(hh));
            cross_item(c, rb * 8 + 2 * c.wave + u, hh, c.lds + (2 * c.wave + u) * 16 * 272);
        }
        __syncthreads();
    }
}
DEV void phase_crossout(const Ctx& c) {
    const Params& p = *c.p; const int tid = c.tid, sr = tid >> 2, sc = (tid & 3) * 8;
    for (int id = c.vb; id < 64 * 8; id += c.G) {
        const int grp = id >> 5, rem = id & 31, ct = rem >> 2, rb = grp * 4 + (rem & 3), row0 = rb * 256;
        const bf16_t* A = WSP(bf16_t, WS_O) + (size_t)((row0 >> 4) + (tid >> 6)) * 16 * 512 + (tid & 63) * 8; const bf16_t* Bt = WSP(bf16_t, WS_WCOT);
        const bf16_t* Ar[4] = { A, A + (size_t)4 * 16 * 512, A + (size_t)8 * 16 * 512, A + (size_t)12 * 16 * 512 };
        const int br0 = perm_row(sr);
        const bf16_t* Br[1][2] = { { Bt + (size_t)(ct * 128 + br0) * 512 + sc, Bt + (size_t)(ct * 128 + br0 + 64) * 512 + sc } };
        EpiResid e{nullptr, WSP(bf16_t, WS_XB), WSP(bf16_t, WS_XB), nullptr, nullptr, (unsigned char*)p.out, row0, ct * 128, ct};
        gemm_tile<1, 8, false, false, true>(c.lds, Ar, Br, 512, e, -1, 512);
    }
}

DEV void phase_route(const Ctx& c, unsigned* cnt, int* list, float* gates_o, float* rstd2_o) {
    const Params& p = *c.p;
    const int lane = c.lane, fr = lane & 15, fq = lane >> 4, wave = c.wave;
    const bf16_t* WH = WSP(bf16_t, WS_WRH); const bf16_t* WL = WSP(bf16_t, WS_WRL);
    float* red = (float*)c.lds;
    float* lg = (float*)(c.lds + 16384);
    int* sel = (int*)(c.lds + 20480);
    int nit = 0;
    for (int it = c.vb; it < M / 16; it += c.G, ++nit) {
        const int tok0 = it * 16;
        const bf16_t* xrow = WSP(bf16_t, WS_XB) + (size_t)(tok0 + fr) * D + wave * 256 + 8 * fq;
        bf16x8 xv[8];
#pragma unroll
        for (int ks = 0; ks < 8; ++ks) xv[ks] = *(const bf16x8*)(xrow + ks * 32);
        f32x4 acc[3]; float ssq = 0.f;
#pragma unroll
        for (int nt = 0; nt < 3; ++nt) acc[nt] = (f32x4){0.f, 0.f, 0.f, 0.f};
#pragma unroll
        for (int kp = 0; kp < 4; ++kp) {
            bf16x8 wa[2][3], wb[2][3];
#pragma unroll
            for (int u = 0; u < 2; ++u)
#pragma unroll
                for (int nt = 0; nt < 3; ++nt) { wa[u][nt] = *frag_ptr(WH, nt, wave * 8 + 2 * kp + u, 32, lane); wb[u][nt] = *frag_ptr(WL, nt, wave * 8 + 2 * kp + u, 32, lane); }
            __builtin_amdgcn_sched_barrier(0);
#pragma unroll
            for (int u = 0; u < 2; ++u) {
                const bf16x8 xh = xv[2 * kp + u];
                const u32x4 xw = __builtin_bit_cast(u32x4, xh);
#pragma unroll
                for (int j = 0; j < 4; ++j) { const float a = bflo(xw[j]), b2 = bfhi(xw[j]); ssq += a * a + b2 * b2; }
#pragma unroll
                for (int nt = 0; nt < 3; ++nt) { acc[nt] = mfma16(wa[u][nt], xh, acc[nt]); acc[nt] = mfma16(wb[u][nt], xh, acc[nt]); }
            }
        }
        ssq += __shfl_xor(ssq, 16); ssq += __shfl_xor(ssq, 32);
        {
            float* r = red + (wave * 64 + lane) * 13;
#pragma unroll
            for (int nt = 0; nt < 3; ++nt)
#pragma unroll
                for (int q = 0; q < 4; ++q) r[nt * 4 + q] = acc[nt][q];
            r[12] = ssq;
        }
        __syncthreads();
        if (wave == 0) {
            float t[13];
#pragma unroll
            for (int q = 0; q < 13; ++q) t[q] = (red[lane * 13 + q] + red[(64 + lane) * 13 + q]) + (red[(128 + lane) * 13 + q] + red[(192 + lane) * 13 + q]);
            const float rs = rsqrtf(t[12] * (1.f / D) + EPS);
#pragma unroll
            for (int nt = 0; nt < 3; ++nt)
#pragma unroll
                for (int q = 0; q < 4; ++q) lg[fr * 52 + nt * 16 + 4 * fq + q] = t[nt * 4 + q] * rs;
            LDS_FENCE();
            if (lane < 16) {
                const float* l = lg + lane * 52;
                const float* bg = p.in[I_B_RG]; const float* be = p.in[I_B_RE];
                int gs = 0; float gm = l[0] + bg[0];
                for (int j = 1; j < 4; ++j) { const float v = l[j] + bg[j]; if (v > gm) { gm = v; gs = j; } }
                float gsum = 0.f;
                for (int j = 0; j < 4; ++j) gsum += __expf(l[j] + bg[j] - gm);
                const float gw_ = 1.f / gsum;
                int i1 = 0; float v1 = l[4 + gs * 8] + be[gs * 8];
                for (int j = 1; j < 8; ++j) { const float v = l[4 + gs * 8 + j] + be[gs * 8 + j]; if (v > v1) { v1 = v; i1 = j; } }
                int i2 = -1; float v2 = -INFINITY;
                for (int j = 0; j < 8; ++j) { const float v = l[4 + gs * 8 + j] + be[gs * 8 + j]; if (j != i1 && v > v2) { v2 = v; i2 = j; } }
                const float e2 = __expf(v2 - v1);
                const float p1 = gw_ / (1.f + e2), p2 = gw_ * e2 / (1.f + e2);
                const int tok = tok0 + lane;
                rstd2_o[tok] = rs;
                sel[nit * 32 + lane * 2] = gs * 8 + i1; sel[nit * 32 + lane * 2 + 1] = gs * 8 + i2;
                gates_o[tok * 2] = p1; gates_o[tok * 2 + 1] = p2;
            }
        }
        __syncthreads();
    }
    if (c.tid < NEXP) {
        const int e = c.tid, na = nit * 32;
        int n = 0;
        for (int a = 0; a < na; ++a) n += (sel[a] == e) ? 1 : 0;
        if (n > 0) {
            unsigned pos = atomicAdd(&cnt[e * 64], (unsigned)n);
            for (int a = 0; a < na; ++a) if (sel[a] == e) { const int tok = (c.vb + (a >> 5) * c.G) * 16 + ((a & 31) >> 1); list[(size_t)e * M + pos] = tok * 2 + (a & 1); ++pos; }
        }
    }
    __syncthreads();
}

DEV int moe_table(const Ctx& c, int* rbstart) {
    const unsigned* cnt = WSP(unsigned, WS_CTL) + CW_CNT;
    if (c.tid == 0) { int acc = 0; for (int e = 0; e < NEXP; ++e) { rbstart[e] = acc; acc += ((int)cnt[e * 64] + 127) >> 7; } rbstart[NEXP] = acc; }
    __syncthreads();
    return rbstart[NEXP];
}
DEV void moe_up_unit(const Ctx& c, const int* rbstart, int id) {
    const Params& p = *c.p;
    const unsigned* cnt = WSP(unsigned, WS_CTL) + CW_CNT;
    const int tid = c.tid, sr = tid >> 2, sc = (tid & 3) * 8;
    const int rbg = id >> 3, ct = id & 7;
    int e = 0;
    for (int j = 1; j < NEXP; ++j) if (rbstart[j] <= rbg) e = j;
    const int rb = rbg - rbstart[e], ne = (int)cnt[e * 64], nvalid = min(128, ne - rb * 128);
    const int* list = WSP(int, WS_LIST) + (size_t)e * M + rb * 128;
    const int slot0 = rbg * 128;
    if (ct == 0 && tid < nvalid) WSP(int, WS_SLOTOF)[list[tid]] = slot0 + tid;
    const int t0 = (sr < nvalid) ? (list[sr] >> 1) : 0, t1 = (sr + 64 < nvalid) ? (list[sr + 64] >> 1) : 0;
    const bf16_t* A = (const bf16_t*)p.out;
    const bf16_t* Bg = WSP(bf16_t, WS_WGT) + (size_t)e * DEXP * (D / 2); const bf16_t* Bu = WSP(bf16_t, WS_WUT) + (size_t)e * DEXP * (D / 2);
    const bf16_t* Ar[2] = { A + (size_t)t0 * (D / 2) + sc, A + (size_t)t1 * (D / 2) + sc };
    const int br0 = perm_row64(sr);
    const bf16_t* Br[2][1] = { { Bg + (size_t)(ct * 64 + br0) * (D / 2) + sc }, { Bu + (size_t)(ct * 64 + br0) * (D / 2) + sc } };
    EpiMoeUp ep{WSP(unsigned char, WS_HB), WSP(float, WS_RSTD2), list, nvalid, slot0, ct * 64};
    gemm_tile_f8<2, 2, false>(c.lds, Ar, Br, D / 2, ep);
}
DEV void moe_down_unit(const Ctx& c, const int* rbstart, int id) {
    const unsigned* cnt = WSP(unsigned, WS_CTL) + CW_CNT;
    const int tid = c.tid, sr = tid >> 2, sc = (tid & 3) * 8;
    const int rbg = id >> 3, ct = id & 7;
    int e = 0;
    for (int j = 1; j < NEXP; ++j) if (rbstart[j] <= rbg) e = j;
    const int rb = rbg - rbstart[e], ne = (int)cnt[e * 64], nvalid = min(128, ne - rb * 128);
    const int* list = WSP(int, WS_LIST) + (size_t)e * M + rb * 128;
    const int slot0 = rbg * 128;
    const bf16_t* A = WSP(bf16_t, WS_HB); const bf16_t* Bd = WSP(bf16_t, WS_WDT) + (size_t)e * D * (DEXP / 2);
    const bf16_t* A0 = A + (size_t)((slot0 >> 4) + (tid >> 6)) * 8 * 512 + (tid & 63) * 8;
    const bf16_t* Ar[2] = { A0, A0 + (size_t)4 * 8 * 512 };
    const int br0 = perm_row(sr);
    const bf16_t* Br[1][2] = { { Bd + (size_t)(ct * 128 + br0) * (DEXP / 2) + sc, Bd + (size_t)(ct * 128 + br0 + 64) * (DEXP / 2) + sc } };
    EpiMoeDown ep{WSP(unsigned char, WS_Y), WSP(float, WS_GATES), list, nvalid, slot0, ct * 128};
    gemm_tile_f8<1, 4, true>(c.lds, Ar, Br, DEXP / 2, ep, 512);
}
constexpr int MOE_COMP = 2;
DEV void phase_moe_a(const Ctx& c) {
    int* rbstart = (int*)(c.lds + 65536);
    const int R = moe_table(c, rbstart), U = R * 8, full = (U / c.G) * c.G;
    for (int id = c.vb; id < full; id += c.G) moe_up_unit(c, rbstart, id);
}
DEV void phase_moe_b(const Ctx& c) {
    int* rbstart = (int*)(c.lds + 65536);
    const int R = moe_table(c, rbstart), U = R * 8, full = (U / c.G) * c.G, T = U - full, D1 = (full >> 3) * 8;
    if (c.vb < T) moe_up_unit(c, rbstart, full + c.vb);
    const int ncomp = min(D1, MOE_COMP * (c.G - T));
    if (c.vb >= T) { for (int q = 0; q < MOE_COMP; ++q) { const int j = (c.vb - T) * MOE_COMP + q; if (j < ncomp) moe_down_unit(c, rbstart, j); } }
    for (int j = ncomp + c.vb; j < D1; j += c.G) moe_down_unit(c, rbstart, j);
}
DEV void phase_moe_c(const Ctx& c) {
    int* rbstart = (int*)(c.lds + 65536);
    const int R = moe_table(c, rbstart), U = R * 8, full = (U / c.G) * c.G, D1 = (full >> 3) * 8;
    for (int j = D1 + c.vb; j < R * 8; j += c.G) moe_down_unit(c, rbstart, j);
}

DEV void phase_final(const Ctx& c, float* dst) {
    const Params& p = *c.p; const int lane = c.lane;
    const int gw = c.vb * 4 + c.wave, NGW = c.G * 4;
    const int* slotof = WSP(int, WS_SLOTOF); const unsigned char* Y = WSP(unsigned char, WS_Y);
    for (int tok = gw; tok < M; tok += NGW) {
        const int s0 = slotof[tok * 2], s1 = slotof[tok * 2 + 1];
        const u32x2* xr = (const u32x2*)(WSP(bf16_t, WS_XB) + (size_t)tok * D) + lane;
        const unsigned* y0 = (const unsigned*)(Y + (size_t)s0 * D) + lane; const unsigned* y1 = (const unsigned*)(Y + (size_t)s1 * D) + lane;
        f32x4 v[4]; float s = 0.f;
#pragma unroll
        for (int j = 0; j < 4; ++j) {
            const u32x2 xw = __builtin_nontemporal_load(xr + 64 * j); const unsigned a = __builtin_nontemporal_load(y0 + 64 * j), bq = __builtin_nontemporal_load(y1 + 64 * j);
            const float sc = 1.f / F8_HSCALE;
            v[j][0] = (bflo(xw.x) + __builtin_amdgcn_cvt_f32_fp8((int)a, 0) * sc) + __builtin_amdgcn_cvt_f32_fp8((int)bq, 0) * sc;
            v[j][1] = (bfhi(xw.x) + __builtin_amdgcn_cvt_f32_fp8((int)a, 1) * sc) + __builtin_amdgcn_cvt_f32_fp8((int)bq, 1) * sc;
            v[j][2] = (bflo(xw.y) + __builtin_amdgcn_cvt_f32_fp8((int)a, 2) * sc) + __builtin_amdgcn_cvt_f32_fp8((int)bq, 2) * sc;
            v[j][3] = (bfhi(xw.y) + __builtin_amdgcn_cvt_f32_fp8((int)a, 3) * sc) + __builtin_amdgcn_cvt_f32_fp8((int)bq, 3) * sc;
            s += (v[j][0] * v[j][0] + v[j][1] * v[j][1]) + (v[j][2] * v[j][2] + v[j][3] * v[j][3]);
        }
        const float rstd = rsqrtf(wave_sum(s) * (1.f / D) + EPS);
        const f32x4* g = (const f32x4*)p.in[I_NORM_FINAL] + lane;
        f32x4* orow = (f32x4*)(dst + (size_t)tok * D) + lane;
#pragma unroll
        for (int j = 0; j < 4; ++j) __builtin_nontemporal_store(v[j] * rstd * g[64 * j], orow + 64 * j);
    }
}

__global__ void __launch_bounds__(256, 2) mk_fwd(Params p) {
    __shared__ __attribute__((aligned(16))) unsigned char lds[LDS_BYTES];
    Ctx c; c.p = &p; c.ws = p.ws; c.lds = lds;
    c.tid = threadIdx.x; c.lane = c.tid & 63; c.wave = __builtin_amdgcn_readfirstlane(c.tid >> 6);
    c.G = gridDim.x; { const int bx = blockIdx.x; c.vb = (c.G % 8 == 0) ? (bx % 8) * (c.G / 8) + bx / 8 : bx; }
    volatile LAS unsigned* st = (volatile LAS unsigned*)(lds + LDS_ST_OFF);
    XcdBarrier bar; bar.bar = (unsigned*)p.ws + CW_BAR; bar.x = 0; bar.st = st;
    const bool multi = (p.ph_hi - p.ph_lo) > 1;
    if (multi) {
        if (c.tid < 4) st[c.tid] = 0u;
        __syncthreads();
        bar = xcd_barrier_post((unsigned*)p.ws + CW_BAR, st);
    }
    int conv_done = 0;
#define PH(k, call) do { if (p.ph_lo <= (k) && (k) < p.ph_hi) { if ((k) == 10) expert_convert_rest(c, conv_done); call; \
        if ((k) + 1 < p.ph_hi) { if ((k) < 10) xcd_barrier_work(bar, c, conv_done, CONV_QUOTA); else xcd_barrier(bar); } } } while (0)
    PH(0, phase_prologue(c));
    PH(1, phase_inproj(c));
    PH(2, phase_mix_a(c));
    PH(3, phase_mlstm_scan(c));
    PH(4, phase_mlstm_c(c));
    PH(6, phase_outproj(c));
    PH(7, phase_crossqa(c));
    PH(9, phase_crossout(c));
    PH(10, phase_route(c, WSP(unsigned, WS_CTL) + CW_CNT, WSP(int, WS_LIST), WSP(float, WS_GATES), WSP(float, WS_RSTD2)));
    PH(11, phase_moe_a(c));
    PH(12, phase_moe_b(c));
    PH(13, phase_moe_c(c));
    PH(14, phase_final(c, p.out));
#undef PH
}

extern "C" void kernel_launch(void* const* d_in, const int* in_sizes, int n_in, void* d_out, int out_size, void* d_ws, size_t ws_size, hipStream_t stream) {
    static int grid = 0;
    if (grid == 0) {
        if (n_in != N_IN || in_sizes[0] != M * D || out_size != M * D || ws_size < WS_END) {
            fprintf(stderr, "kernel_launch: unexpected shapes (n_in %d, in0 %d, out %d, ws %zu); nothing launched\n", n_in, n_in > 0 ? in_sizes[0] : -1, out_size, ws_size);
            grid = -1; return;
        }
        int dev = 0, cus = 0, per_cu = 0;
        if (hipGetDevice(&dev) != hipSuccess || hipDeviceGetAttribute(&cus, hipDeviceAttributeMultiprocessorCount, dev) != hipSuccess) { grid = -1; return; }
        if (hipOccupancyMaxActiveBlocksPerMultiprocessor(&per_cu, (const void*)mk_fwd, 256, 0) != hipSuccess) per_cu = 0;
        (void)hipGetLastError();
        if (per_cu < 2) fprintf(stderr, "kernel_launch: note: occupancy query reports %d workgroups per CU\n", per_cu);
        grid = cus * (per_cu >= 2 ? 2 : 1);
    }
    if (grid < 0) return;
    (void)hipMemsetAsync((char*)d_ws + WS_CTL, 0, CTL_BYTES, stream);
    Params p{};
    for (int i = 0; i < N_IN; ++i) p.in[i] = (const float*)d_in[i];
    p.out = (float*)d_out; p.ws = (unsigned char*)d_ws;
#if MK_N_LAUNCHES == 1
    p.ph_lo = 0; p.ph_hi = NPHASE;
    hipLaunchKernelGGL(mk_fwd, dim3(grid), dim3(256), 0, stream, p);
#else
    for (int ph = 0; ph < NPHASE; ++ph) { p.ph_lo = ph; p.ph_hi = ph + 1; hipLaunchKernelGGL(mk_fwd, dim3(grid), dim3(256), 0, stream, p); }
#endif
}
```

```cpp
#include <hip/hip_runtime.h>
#include <cstdio>
#include <cstdint>

#ifndef MK_N_LAUNCHES
#define MK_N_LAUNCHES 1
#endif

#define DEV __device__ __forceinline__
#define LAS __attribute__((address_space(3)))
typedef unsigned short bf16_t;
typedef short bf16x8 __attribute__((ext_vector_type(8)));
typedef float f32x4 __attribute__((ext_vector_type(4)));
typedef float f32x16 __attribute__((ext_vector_type(16)));
typedef unsigned u32x4 __attribute__((ext_vector_type(4)));
typedef unsigned u32x2 __attribute__((ext_vector_type(2)));

constexpr int M = 16384, D = 1024, SEQ = 4096, NBATCH = 4;
constexpr int IN_COLS = 2824, NPAD = 2944;
constexpr int MEMROWS = 1024;
constexpr int NEXP = 32, DEXP = 512;
constexpr float EPS = 1e-6f;
constexpr int NPHASE = 15;

enum { I_X = 0, I_MEM, I_NORM_MIX, I_W_IN, I_B_GATES, I_CONV_W, I_CONV_B, I_SINKS, I_NORM_ATT, I_NORM_ML, I_W_OUT, I_NORM_CROSS, I_NORM_MEM,
       I_W_CQ, I_W_CKV, I_W_CO, I_NORM_FFN, I_W_RG, I_B_RG, I_W_RE, I_B_RE, I_W_EG, I_W_EU, I_W_ED, I_NORM_FINAL, N_IN };

constexpr size_t KiB = 1024, MiB = 1024 * 1024;
constexpr size_t WS_CTL    = 0;
constexpr size_t CTL_BYTES = 64 * KiB;
constexpr size_t WS_RSTD0  = 64 * KiB;
constexpr size_t WS_RSTDM  = 128 * KiB;
constexpr size_t WS_RSTD2  = 192 * KiB;
constexpr size_t WS_GATES  = 256 * KiB;
constexpr size_t WS_SLOTOF = 384 * KiB;
constexpr size_t WS_G      = 512 * KiB;
constexpr size_t WS_SS1    = 1 * MiB;
constexpr size_t WS_LIST   = 2 * MiB;
constexpr size_t WS_SC     = 4 * MiB;
constexpr size_t WS_MP     = 4 * MiB + 16 * KiB;
constexpr size_t WS_UN     = 4 * MiB + 512 * KiB;
constexpr size_t WS_NP     = 5 * MiB;
constexpr size_t WS_WRH    = 6 * MiB;
constexpr size_t WS_WRL    = 6 * MiB + 128 * KiB;
constexpr size_t WS_ATTSS  = 7 * MiB;
constexpr size_t WS_WINT   = 8 * MiB;
constexpr size_t WS_WOUTT  = 14 * MiB;
constexpr size_t WS_WCQT   = 16 * MiB;
constexpr size_t WS_WCKVT  = 17 * MiB;
constexpr size_t WS_WCOT   = 19 * MiB;
constexpr size_t WS_KMEM   = 22 * MiB;
constexpr size_t WS_VMEMT  = 23 * MiB;
constexpr size_t WS_XB     = 24 * MiB;
constexpr size_t WS_MEMB   = 56 * MiB;
constexpr size_t WS_XB0FA  = 106 * MiB, WS_XB0FB = 138 * MiB, WS_MEMBF = 74 * MiB;
constexpr size_t WS_WGT    = 58 * MiB;
constexpr size_t WS_WUT    = 90 * MiB;
constexpr size_t WS_WDT    = 122 * MiB;
constexpr size_t WS_QA     = 154 * MiB;
constexpr size_t WS_KA     = 170 * MiB;
constexpr size_t WS_VAT    = 174 * MiB;
constexpr size_t WS_QKR    = 178 * MiB;
constexpr size_t WS_VMT    = 210 * MiB;
constexpr size_t WS_OM     = 226 * MiB;
constexpr size_t WS_MIX    = 242 * MiB;
constexpr size_t WS_Q      = 154 * MiB;
constexpr size_t WS_O      = 170 * MiB;
constexpr size_t WS_HB     = 154 * MiB;
constexpr size_t WS_Y      = 190 * MiB;
constexpr size_t WS_END    = 274 * MiB;
constexpr int CW_CNT = 0;
constexpr int CW_BAR = 4096;

constexpr int LDS_BYTES = 74752;
constexpr int LDS_ST_OFF = LDS_BYTES - 16;

struct Params { const float* in[N_IN]; float* out; unsigned char* ws; int ph_lo, ph_hi; };

DEV unsigned f2bf(float f) { unsigned u = __builtin_bit_cast(unsigned, f); return (u + 0x7fffu + ((u >> 16) & 1u)) >> 16; }
typedef __bf16 bf16v2_t __attribute__((ext_vector_type(2)));
typedef float f32x2_t __attribute__((ext_vector_type(2)));
DEV unsigned pk2(float lo, float hi) { const f32x2_t v = {lo, hi}; return __builtin_bit_cast(unsigned, __builtin_convertvector(v, bf16v2_t)); }
DEV float bf2f(unsigned h) { return __builtin_bit_cast(float, h << 16); }
DEV float bflo(unsigned w) { return __builtin_bit_cast(float, w << 16); }
DEV float bfhi(unsigned w) { return __builtin_bit_cast(float, w & 0xffff0000u); }
DEV u32x2 pk4(f32x4 v) { u32x2 r; r.x = pk2(v[0], v[1]); r.y = pk2(v[2], v[3]); return r; }
DEV bf16x8 frag_from(u32x2 a, u32x2 b) { u32x4 r; r.x = a.x; r.y = a.y; r.z = b.x; r.w = b.y; return __builtin_bit_cast(bf16x8, r); }
DEV f32x4 mfma16(bf16x8 a, bf16x8 b, f32x4 c) { return __builtin_amdgcn_mfma_f32_16x16x32_bf16(a, b, c, 0, 0, 0); }
typedef long i64x2 __attribute__((ext_vector_type(2)));
DEV f32x4 mfma16_f8(bf16x8 a, bf16x8 b, f32x4 c) {
    const i64x2 av = __builtin_bit_cast(i64x2, a), bv = __builtin_bit_cast(i64x2, b);
    c = __builtin_amdgcn_mfma_f32_16x16x32_fp8_fp8(av[0], bv[0], c, 0, 0, 0);
    return __builtin_amdgcn_mfma_f32_16x16x32_fp8_fp8(av[1], bv[1], c, 0, 0, 0);
}
DEV unsigned pk4_f8(float a, float b, float c, float d) { int r = __builtin_amdgcn_cvt_pk_fp8_f32(a, b, 0, false); r = __builtin_amdgcn_cvt_pk_fp8_f32(c, d, r, true); return (unsigned)r; }
constexpr float F8_WSCALE = 64.f;
constexpr float F8_HSCALE = 16.f;
DEV float sigmoidf_(float x) { return __builtin_amdgcn_rcpf(1.f + __expf(-x)); }
DEV float siluf_(float x) { return x * __builtin_amdgcn_rcpf(1.f + __expf(-x)); }
DEV float wave_sum(float v) {
#pragma unroll
    for (int o = 1; o < 64; o <<= 1) v += __shfl_xor(v, o);
    return v;
}
DEV float wave_max(float v) {
#pragma unroll
    for (int o = 1; o < 64; o <<= 1) v = fmaxf(v, __shfl_xor(v, o));
    return v;
}
#define LDS_FENCE() asm volatile("s_waitcnt lgkmcnt(0)" ::: "memory")
DEV size_t frag16_off(int row, int col, int C32) { return ((size_t)((row >> 4) * C32 + (col >> 5)) * 64 + ((col >> 3) & 3) * 16 + (row & 15)) * 8 + (col & 7); }
DEV size_t fragp_off(int row, int col, int C32) { return ((size_t)((row >> 4) * C32 + (col >> 5)) * 64 + ((col >> 2) & 3) * 16 + (row & 15)) * 8 + ((col >> 4) & 1) * 4 + (col & 3); }
DEV const bf16x8* frag_ptr(const bf16_t* base, int rt, int ct, int C32, int lane) { return (const bf16x8*)(base + ((size_t)(rt * C32 + ct) * 64 + lane) * 8); }

#define XB_TMO      128
#define XB_XCNT(j)  (256  + 64 * (j))
#define XB_XSUB(j)  (1280 + 64 * (j))
#define XB_XGEN(j)  (2304 + 64 * (j))
#define XB_TOP      3328
#define XB_TOPGEN   3392
#define XCD_BAR_WORDS 3456
#define XB_SPIN_CAP (1u << 22)
DEV unsigned xb_ld(unsigned* p)              { return __hip_atomic_load(p, __ATOMIC_RELAXED, __HIP_MEMORY_SCOPE_AGENT); }
DEV unsigned xb_add(unsigned* p, unsigned v) { return __hip_atomic_fetch_add(p, v, __ATOMIC_RELAXED, __HIP_MEMORY_SCOPE_AGENT); }
DEV unsigned xb_xcc_id() { return (unsigned)__builtin_amdgcn_s_getreg((3 << 11) | 20) & 0xFu; }
#define XB_SPIN(cond, bar) do { unsigned _sp = 0; while (cond) { __builtin_amdgcn_s_sleep(1); \
    if ((++_sp & 255u) == 0u) { if (xb_ld(&(bar)[XB_TMO])) break; if (_sp > XB_SPIN_CAP) { atomicAdd(&(bar)[XB_TMO], 1u); break; } } } } while (0)
struct XcdBarrier { unsigned* bar; unsigned x; volatile LAS unsigned* st; };
DEV XcdBarrier xcd_barrier_post(unsigned* bar, volatile LAS unsigned* st) {
    XcdBarrier b; b.bar = bar; b.x = xb_xcc_id(); b.st = st;
    if (threadIdx.x == 0) (void)xb_add(&bar[XB_XCNT(b.x)], 1u);
    return b;
}
DEV void xcd_barrier_complete(unsigned* bar, unsigned x, unsigned& nloc, unsigned& nx) {
    const unsigned G = gridDim.x * gridDim.y * gridDim.z;
    unsigned sum, cnt, mine, sp = 0u;
    for (;;) {
        sum = 0u; cnt = 0u; mine = 0u;
#pragma unroll
        for (unsigned j = 0; j < 16; ++j) { const unsigned c = xb_ld(&bar[XB_XCNT(j)]); sum += c; cnt += (c > 0u) ? 1u : 0u; mine = (j == x) ? c : mine; }
        if (sum == G) break;
        __builtin_amdgcn_s_sleep(1);
        if ((++sp & 255u) == 0u) { if (xb_ld(&bar[XB_TMO])) break; if (sp > XB_SPIN_CAP) { atomicAdd(&bar[XB_TMO], 1u); break; } }
    }
    nloc = mine > 0u ? mine : 1u; nx = cnt > 0u ? cnt : 1u;
}
DEV void xcd_barrier(const XcdBarrier& b) {
    asm volatile("s_waitcnt vmcnt(0)" ::: "memory");
    __syncthreads();
    if (threadIdx.x == 0) {
        unsigned* bar = b.bar;
        __builtin_amdgcn_s_waitcnt(0);
        unsigned nloc = b.st[0], nx = b.st[1];
        if (nloc == 0u) { xcd_barrier_complete(bar, b.x, nloc, nx); b.st[0] = nloc; b.st[1] = nx; }
        const unsigned old = xb_add(&bar[XB_XSUB(b.x)], 1u);
        const unsigned gen = old / nloc;
        asm volatile("buffer_inv sc1" ::: "memory");
        if (old + 1u == (gen + 1u) * nloc) {
            __builtin_amdgcn_fence(__ATOMIC_RELEASE, "agent");
            asm volatile("s_waitcnt vmcnt(0)" ::: "memory");
            const unsigned og = xb_add(&bar[XB_TOP], 1u);
            const unsigned tg = og / nx;
            if (og + 1u == (tg + 1u) * nx) xb_add(&bar[XB_TOPGEN], 1u);
            else XB_SPIN(xb_ld(&bar[XB_TOPGEN]) == tg, bar);
            xb_add(&bar[XB_XGEN(b.x)], 1u);
            asm volatile("s_waitcnt vmcnt(0)" ::: "memory");
        } else {
            XB_SPIN(xb_ld(&bar[XB_XGEN(b.x)]) == gen, bar);
            asm volatile("s_waitcnt vmcnt(0)" ::: "memory");
        }
    }
    __syncthreads();
}

template <int NB, int MT, bool TR, bool MID = false, bool AFRAG = false, bool F8 = false, class Epi>
DEV void gemm_tile(unsigned char* lds, const bf16_t* const (&Ar)[MT / 2], const bf16_t* const (&Br)[NB][2], int K, const Epi& epi, int ksplit = -1, int astep = 32, int bstep = 32) {
    const int tid = threadIdx.x, lane = tid & 63, wid = tid >> 6, wr = wid >> 1, wc = wid & 1, fr = lane & 15, fq = lane >> 4;
    constexpr int RH = MT * 16;
    f32x4 acc[NB][MT][4];
#pragma unroll
    for (int nb = 0; nb < NB; ++nb)
#pragma unroll
        for (int m = 0; m < MT; ++m)
#pragma unroll
            for (int n = 0; n < 4; ++n) acc[nb][m][n] = (f32x4){0.f, 0.f, 0.f, 0.f};
    constexpr int KSUB = (NB == 1 && MT == 4) ? 2 : 1;
    constexpr int ASZ = MT * 2048;
    constexpr int SUBT = ASZ + 8192 * NB;
    constexpr int STAGE = SUBT * KSUB;
    const int nk = K / (32 * KSUB);
#define GT_STAGE(kt_, buf_) do { _Pragma("unroll") for (int su = 0; su < KSUB; ++su) { \
        _Pragma("unroll") for (int i = 0; i < MT / 2; ++i) \
            __builtin_amdgcn_global_load_lds((const unsigned*)(Ar[i] + ((kt_) * KSUB + su) * astep), (LAS unsigned*)(lds + (buf_) * STAGE + su * SUBT + tid * 16 + i * 4096), 16, 0, 0); \
        _Pragma("unroll") for (int i = 0; i < 2; ++i) _Pragma("unroll") for (int nb = 0; nb < NB; ++nb) \
            __builtin_amdgcn_global_load_lds((const unsigned*)(Br[nb][i] + ((kt_) * KSUB + su) * bstep), (LAS unsigned*)(lds + (buf_) * STAGE + su * SUBT + ASZ + 8192 * nb + tid * 16 + i * 4096), 16, 0, 0); } } while (0)
    GT_STAGE(0, 0);
    float msv[MID ? MT : 1];
    if constexpr (MID) {
#pragma unroll
        for (int m = 0; m < MT; ++m) msv[m] = epi.midscale(wr * RH + m * 16 + fr);
    }
    for (int kt = 0; kt < nk; ++kt) {
        const int cur = kt & 1;
        asm volatile("s_waitcnt vmcnt(0)" ::: "memory");
        __syncthreads();
        if (kt + 1 < nk) GT_STAGE(kt + 1, cur ^ 1);
        if constexpr (MID) {
            if (kt * KSUB == ksplit) {
#pragma unroll
                for (int m = 0; m < MT; ++m) { const float ms = msv[m];
#pragma unroll
                    for (int n = 0; n < 4; ++n) acc[0][m][n] = acc[0][m][n] * ms; }
            }
        }
#pragma unroll
        for (int su = 0; su < KSUB; ++su) {
            const unsigned char* sb = lds + cur * STAGE + su * SUBT;
            bf16x8 af[MT], bfr[NB][4];
#pragma unroll
            for (int m = 0; m < MT; ++m) af[m] = AFRAG ? *(const bf16x8*)(sb + (wr * MT + m) * 1024 + lane * 16) : *(const bf16x8*)(sb + ((wr * RH + m * 16 + fr) * 32 + fq * 8) * 2);
#pragma unroll
            for (int nb = 0; nb < NB; ++nb)
#pragma unroll
                for (int n = 0; n < 4; ++n) bfr[nb][n] = *(const bf16x8*)(sb + ASZ + 8192 * nb + ((wc * 64 + n * 16 + fr) * 32 + fq * 8) * 2);
#pragma unroll
            for (int nb = 0; nb < NB; ++nb)
#pragma unroll
                for (int m = 0; m < MT; ++m)
#pragma unroll
                    for (int n = 0; n < 4; ++n)
                        acc[nb][m][n] = F8 ? mfma16_f8(bfr[nb][n], af[m], acc[nb][m][n]) : (TR ? mfma16(af[m], bfr[nb][n], acc[nb][m][n]) : mfma16(bfr[nb][n], af[m], acc[nb][m][n]));
        }
    }
#undef GT_STAGE
    if constexpr (Epi::SYNC_EPI) __syncthreads();
    if constexpr (!TR) {
        float rsv[MT];
#pragma unroll
        for (int m = 0; m < MT; ++m) rsv[m] = epi.rowscale(wr * RH + m * 16 + fr);
        f32x4 pre[2][4];
#pragma unroll
        for (int q = 0; q < 2; ++q) { pre[0][2 * q] = epi.pre(wr * RH + fr, wc * 64 + q * 32 + 8 * fq); pre[0][2 * q + 1] = epi.pre(wr * RH + fr, wc * 64 + q * 32 + 8 * fq + 4); }
#pragma unroll
        for (int m = 0; m < MT; ++m) {
            const int rl = wr * RH + m * 16 + fr;
            const float rs = rsv[m];
            float ss = 0.f;
            if (m + 1 < MT) {
#pragma unroll
                for (int q = 0; q < 2; ++q) { pre[(m + 1) & 1][2 * q] = epi.pre(rl + 16, wc * 64 + q * 32 + 8 * fq); pre[(m + 1) & 1][2 * q + 1] = epi.pre(rl + 16, wc * 64 + q * 32 + 8 * fq + 4); }
            }
#pragma unroll
            for (int q = 0; q < 2; ++q) {
                const int cl = wc * 64 + q * 32 + 8 * fq;
                if constexpr (NB == 2) ss += epi.store8x2(rl, cl, acc[0][m][2 * q], acc[0][m][2 * q + 1], acc[1][m][2 * q], acc[1][m][2 * q + 1], rs);
                else ss += epi.store8(rl, cl, acc[0][m][2 * q], acc[0][m][2 * q + 1], rs, pre[m & 1][2 * q], pre[m & 1][2 * q + 1]);
            }
            epi.rowend(rl, wc, ss);
            asm volatile("" ::: "memory");
        }
    } else {
#pragma unroll
        for (int mg = 0; mg < MT; mg += 4) {
            f32x4 rs4[4];
#pragma unroll
            for (int m = 0; m < 4; ++m) rs4[m] = epi.rowscale4(wr * RH + (mg + m) * 16 + 4 * fq);
#pragma unroll
            for (int m = 0; m < 4; ++m) {
                const int rl = wr * RH + (mg + m) * 16 + 4 * fq;
#pragma unroll
                for (int n = 0; n < 4; ++n) epi.storeT(rl, wc * 64 + n * 16 + fr, acc[0][mg + m][n] * rs4[m]);
            }
            asm volatile("" ::: "memory");
        }
    }
}

typedef int i32x8 __attribute__((ext_vector_type(8)));
DEV i32x8 cat32(bf16x8 lo, bf16x8 hi) { const u32x4 a = __builtin_bit_cast(u32x4, lo), b = __builtin_bit_cast(u32x4, hi); i32x8 r; r[0] = (int)a.x; r[1] = (int)a.y; r[2] = (int)a.z; r[3] = (int)a.w; r[4] = (int)b.x; r[5] = (int)b.y; r[6] = (int)b.z; r[7] = (int)b.w; return r; }
template <int NB, int NT, bool AFRAG, class Epi>
DEV void gemm_tile_f8(unsigned char* lds, const bf16_t* const (&Ar)[2], const bf16_t* const (&Br)[NB][NT / 2], int K, const Epi& epi, int astep = 32, int bstep = 32) {
    const int tid = threadIdx.x, lane = tid & 63, wid = tid >> 6, wr = wid >> 1, wc = wid & 1, fr = lane & 15, fq = lane >> 4;
    constexpr int MT = 4, RH = 64;
    f32x4 acc[NB][MT][NT];
#pragma unroll
    for (int nb = 0; nb < NB; ++nb)
#pragma unroll
        for (int m = 0; m < MT; ++m)
#pragma unroll
            for (int n = 0; n < NT; ++n) acc[nb][m][n] = (f32x4){0.f, 0.f, 0.f, 0.f};
    constexpr int ASZ = 8192, BSZ = NT * 2048, SUBT = ASZ + BSZ * NB, STAGE = 2 * SUBT;
    const int nk = K >> 6;
#define GT8_STAGE(kt_, buf_) do { _Pragma("unroll") for (int su = 0; su < 2; ++su) { \
        _Pragma("unroll") for (int i = 0; i < NT / 2; ++i) _Pragma("unroll") for (int nb = 0; nb < NB; ++nb) \
            __builtin_amdgcn_global_load_lds((const unsigned*)(Br[nb][i] + ((kt_) * 2 + su) * bstep), (LAS unsigned*)(lds + (buf_) * STAGE + su * SUBT + ASZ + BSZ * nb + tid * 16 + i * 4096), 16, 0, 0); } \
      _Pragma("unroll") for (int su = 0; su < 2; ++su) { \
        _Pragma("unroll") for (int i = 0; i < 2; ++i) \
            __builtin_amdgcn_global_load_lds((const unsigned*)(Ar[i] + ((kt_) * 2 + su) * astep), (LAS unsigned*)(lds + (buf_) * STAGE + su * SUBT + tid * 16 + i * 4096), 16, 0, 0); } } while (0)
    GT8_STAGE(0, 0);
    float rsv[MT];
    epi.rowscales(wr * RH + fr, rsv);
#pragma unroll 1
    for (int kt = 0; kt < nk; ++kt) {
        const int cur = kt & 1;
        asm volatile("s_waitcnt vmcnt(0)" ::: "memory");
        __syncthreads();
        if (kt + 1 < nk) GT8_STAGE(kt + 1, cur ^ 1);
        const unsigned char* s0 = lds + cur * STAGE; const unsigned char* s1 = s0 + SUBT;
        i32x8 af[MT], bfr[NB][NT];
#pragma unroll
        for (int m = 0; m < MT; ++m) {
            const int off = AFRAG ? ((wr * MT + m) * 1024 + lane * 16) : (((wr * RH + m * 16 + fr) * 32 + fq * 8) * 2);
            af[m] = cat32(*(const bf16x8*)(s0 + off), *(const bf16x8*)(s1 + off));
        }
#pragma unroll
        for (int nb = 0; nb < NB; ++nb)
#pragma unroll
            for (int n = 0; n < NT; ++n) {
                const int off = ASZ + BSZ * nb + ((wc * (16 * NT) + n * 16 + fr) * 32 + fq * 8) * 2;
                bfr[nb][n] = cat32(*(const bf16x8*)(s0 + off), *(const bf16x8*)(s1 + off));
            }
#pragma unroll
        for (int nb = 0; nb < NB; ++nb)
#pragma unroll
            for (int m = 0; m < MT; ++m)
#pragma unroll
                for (int n = 0; n < NT; ++n)
                    acc[nb][m][n] = __builtin_amdgcn_mfma_scale_f32_16x16x128_f8f6f4(bfr[nb][n], af[m], acc[nb][m][n], 0, 0, 0, 0x7F7F7F7F, 0, 0x7F7F7F7F);
    }
#undef GT8_STAGE
#pragma unroll
    for (int m = 0; m < MT; ++m) {
        const int rl = wr * RH + m * 16 + fr;
        const float rs = rsv[m];
#pragma unroll
        for (int q = 0; q < NT / 2; ++q) {
            const int cl = wc * (16 * NT) + q * 32 + 8 * fq;
            if constexpr (NB == 2) (void)epi.store8x2(rl, cl, acc[0][m][2 * q], acc[0][m][2 * q + 1], acc[1][m][2 * q], acc[1][m][2 * q + 1], rs);
            else (void)epi.store8(rl, cl, acc[0][m][2 * q], acc[0][m][2 * q + 1], rs, (f32x4){0.f, 0.f, 0.f, 0.f}, (f32x4){0.f, 0.f, 0.f, 0.f});
        }
        asm volatile("" ::: "memory");
    }
}
DEV int perm32_inv(int c) { return 8 * ((c >> 2) & 3) + 4 * ((c >> 4) & 1) + (c & 3); }
template <int NB, int NW, class Epi>
DEV void gemm_tile_f8w(unsigned char* lds, const bf16_t* const (&Ar)[2], const bf16_t* const (&Br)[NB][NW], int K, const Epi& epi, int astep, int bstep) {
    const int tid = threadIdx.x, lane = tid & 63, wid = tid >> 6, wr = wid >> 1, wc = wid & 1, li = lane & 31, kq = lane >> 5;
    f32x16 acc[NB][2][NW];
#pragma unroll
    for (int nb = 0; nb < NB; ++nb)
#pragma unroll
        for (int m = 0; m < 2; ++m)
#pragma unroll
            for (int n = 0; n < NW; ++n)
#pragma unroll
                for (int j = 0; j < 16; ++j) acc[nb][m][n][j] = 0.f;
    constexpr int ASZ = 8192, BSZ = NW * 4096, STAGE = ASZ + NB * BSZ;
    const int nk = K >> 5;
#define GT8W_STAGE(kt_, buf_) do { \
        _Pragma("unroll") for (int i = 0; i < NW; ++i) _Pragma("unroll") for (int nb = 0; nb < NB; ++nb) \
            __builtin_amdgcn_global_load_lds((const unsigned*)(Br[nb][i] + (kt_) * bstep), (LAS unsigned*)(lds + (buf_) * STAGE + ASZ + BSZ * nb + tid * 16 + i * 4096), 16, 0, 0); \
        _Pragma("unroll") for (int i = 0; i < 2; ++i) \
            __builtin_amdgcn_global_load_lds((const unsigned*)(Ar[i] + (kt_) * astep), (LAS unsigned*)(lds + (buf_) * STAGE + tid * 16 + i * 4096), 16, 0, 0); } while (0)
    GT8W_STAGE(0, 0);
    float rsv[2];
    epi.rowscales2(wr * 64 + li, rsv);
    GT8W_STAGE(1, 1);
    const int sw = (li >> 2) & 3, c0 = ((kq * 2) ^ sw) * 16, c1 = ((kq * 2 + 1) ^ sw) * 16;
    int cur = 0, nxt = 2;
#pragma unroll 1
    for (int kt = 0; kt < nk; ++kt) {
        if (kt + 1 < nk) { if constexpr (NB * NW == 4) asm volatile("s_waitcnt vmcnt(6)" ::: "memory"); else if constexpr (NB * NW == 2) asm volatile("s_waitcnt vmcnt(4)" ::: "memory"); else asm volatile("s_waitcnt vmcnt(3)" ::: "memory"); }
        else asm volatile("s_waitcnt vmcnt(0)" ::: "memory");
        __syncthreads();
        if (kt + 2 < nk) GT8W_STAGE(kt + 2, nxt);
        const unsigned char* s0 = lds + cur * STAGE;
        cur = (cur == 2) ? 0 : cur + 1; nxt = (nxt == 2) ? 0 : nxt + 1;
        i32x8 af[2], bfr[NB][NW];
#pragma unroll
        for (int m = 0; m < 2; ++m) { const unsigned char* r = s0 + (wr * 64 + m * 32 + li) * 64; af[m] = cat32(*(const bf16x8*)(r + c0), *(const bf16x8*)(r + c1)); }
#pragma unroll
        for (int nb = 0; nb < NB; ++nb)
#pragma unroll
            for (int n = 0; n < NW; ++n) { const unsigned char* r = s0 + ASZ + BSZ * nb + (wc * (32 * NW) + n * 32 + li) * 64; bfr[nb][n] = cat32(*(const bf16x8*)(r + c0), *(const bf16x8*)(r + c1)); }
#pragma unroll
        for (int nb = 0; nb < NB; ++nb)
#pragma unroll
            for (int m = 0; m < 2; ++m)
#pragma unroll
                for (int n = 0; n < NW; ++n)
                    acc[nb][m][n] = __builtin_amdgcn_mfma_scale_f32_32x32x64_f8f6f4(bfr[nb][n], af[m], acc[nb][m][n], 0, 0, 0, 0x7F7F7F7F, 0, 0x7F7F7F7F);
    }
#undef GT8W_STAGE
    __syncthreads();
#pragma unroll
    for (int m = 0; m < 2; ++m) {
#pragma unroll
        for (int n = 0; n < NW; ++n) {
            if constexpr (NB == 2) epi.store16(wr * 64 + m * 32 + li, wc * (32 * NW) + n * 32 + kq * 16, acc[0][m][n], acc[1][m][n], rsv[m]);
            else epi.store16(wr * 64 + m * 32 + li, wc * (32 * NW) + n * 32 + kq * 16, acc[0][m][n], acc[0][m][n], rsv[m]);
        }
        asm volatile("" ::: "memory");
    }
}
DEV int perm_row64(int r) { const int n = (r >> 4) & 1, i = r & 15; return (r & 32) + 8 * (i >> 2) + 4 * n + (i & 3); }

DEV int perm_row(int r) { const int n = (r >> 4) & 3, i = r & 15; return (r & 64) + (n >> 1) * 32 + 8 * (i >> 2) + 4 * (n & 1) + (i & 3); }
DEV u32x4 pk8(f32x4 a, f32x4 b) { u32x4 r; r.x = pk2(a[0], a[1]); r.y = pk2(a[2], a[3]); r.z = pk2(b[0], b[1]); r.w = pk2(b[2], b[3]); return r; }
struct EpiRowBf16 {
    static constexpr bool SYNC_EPI = false;
    bf16_t* out; int ld; const float* rscale; const float* ss16; float mul; int act; int row0; int col0; int lay;
    DEV float rowscale(int rl) const {
        const int row = row0 + rl;
        if (ss16) { const f32x4* s = (const f32x4*)(ss16 + (size_t)row * 16); f32x4 a = s[0], b = s[1], c = s[2], d = s[3];
                    const float t = ((a[0] + a[1]) + (a[2] + a[3])) + ((b[0] + b[1]) + (b[2] + b[3])) + ((c[0] + c[1]) + (c[2] + c[3])) + ((d[0] + d[1]) + (d[2] + d[3]));
                    return rsqrtf(t * (1.f / D) + EPS) * mul; }
        return (rscale ? rsqrtf(rscale[row] * (1.f / D) + EPS) : 1.f) * mul;
    }
    DEV f32x4 pre(int, int) const { return (f32x4){0.f, 0.f, 0.f, 0.f}; }
    DEV float store8(int rl, int cl, f32x4 v0, f32x4 v1, float rs, f32x4, f32x4) const {
        v0 = v0 * rs; v1 = v1 * rs;
        if (act == 1) {
#pragma unroll
            for (int i = 0; i < 4; ++i) { v0[i] = sigmoidf_(v0[i]); v1[i] = sigmoidf_(v1[i]); }
        }
        const int row = row0 + rl, col = col0 + cl;
        const size_t off = (lay == 0) ? ((size_t)row * ld + col) : frag16_off(row, col, ld >> 5);
        *(u32x4*)(out + off) = pk8(v0, v1);
        return 0.f;
    }
    DEV void rowend(int, int, float) const {}
};
struct EpiGates {
    static constexpr bool SYNC_EPI = false;
    float* G; const float* rscale; const float* bg; int row0;
    DEV float rowscale(int rl) const { return rsqrtf(rscale[row0 + rl] * (1.f / D) + EPS); }
    DEV f32x4 pre(int, int) const { return (f32x4){0.f, 0.f, 0.f, 0.f}; }
    DEV float store8(int rl, int cl, f32x4 v0, f32x4 v1, float rs, f32x4, f32x4) const {
        if (cl == 0) {
            v0 = v0 * rs + *(const f32x4*)bg; v1 = v1 * rs + *(const f32x4*)(bg + 4);
#pragma unroll
            for (int i = 0; i < 4; ++i) { const float f = v1[i]; v1[i] = fminf(f, 0.f) - log1pf(__expf(-fabsf(f))); }
            *(f32x4*)(G + (size_t)(row0 + rl) * 8) = v0; *(f32x4*)(G + (size_t)(row0 + rl) * 8 + 4) = v1;
        }
        return 0.f;
    }
    DEV void rowend(int, int, float) const {}
};
struct EpiTrans {
    static constexpr bool SYNC_EPI = false;
    bf16_t* out; const float* rscale; int row0; int col0; int hs; int nh; int sshift;
    DEV f32x4 rowscale4(int rl) const { const f32x4 s = *(const f32x4*)(rscale + row0 + rl); return (f32x4){rsqrtf(s[0] * (1.f / D) + EPS), rsqrtf(s[1] * (1.f / D) + EPS), rsqrtf(s[2] * (1.f / D) + EPS), rsqrtf(s[3] * (1.f / D) + EPS)}; }
    DEV void storeT(int rl, int cl, f32x4 v) const {
        const int row = row0 + rl, col = col0 + cl;
        const int b = row >> sshift, s = row & ((1 << sshift) - 1), hh = col >> hs, d = col & ((1 << hs) - 1);
        *(u32x2*)(out + fragp_off(((b * nh + hh) << hs) + d, s, (1 << sshift) >> 5)) = pk4(v);
    }
};
struct EpiResid {
    static constexpr bool SYNC_EPI = false;
    const float* resf; const bf16_t* resb; bf16_t* XB; float* SS; const float* attss; unsigned char* X8; int row0; int col0; int ct; const bf16_t* resfr = nullptr; bf16_t* outfr = nullptr;
    DEV float rowscale(int) const { return 1.f; }
    DEV float midscale(int rl) const { const float* a = attss + (size_t)(row0 + rl) * 2; return rsqrtf((a[0] + a[1]) * (1.f / 512.f) + EPS); }
    DEV f32x4 pre(int rl, int cl) const {
        const size_t off = (size_t)(row0 + rl) * D + col0 + cl;
        if (resf) return *(const f32x4*)(resf + off);
        const u32x2 w = resfr ? *(const u32x2*)(resfr + frag16_off(row0 + rl, col0 + cl, 32)) : *(const u32x2*)(resb + off);
        f32x4 r; r[0] = bflo(w.x); r[1] = bfhi(w.x); r[2] = bflo(w.y); r[3] = bfhi(w.y); return r;
    }
    DEV float store8(int rl, int cl, f32x4 v0, f32x4 v1, float, f32x4 r0, f32x4 r1) const {
        const size_t off = (size_t)(row0 + rl) * D + col0 + cl;
        v0 = v0 + r0; v1 = v1 + r1;
        const u32x4 w = pk8(v0, v1);
        if (outfr) *(u32x4*)(outfr + frag16_off(row0 + rl, col0 + cl, 32)) = w; else *(u32x4*)(XB + off) = w;
        if (X8) { u32x2 q; q.x = pk4_f8(v0[0], v0[1], v0[2], v0[3]); q.y = pk4_f8(v1[0], v1[1], v1[2], v1[3]); *(u32x2*)(X8 + off) = q; }
        const float a0 = bflo(w.x), a1 = bfhi(w.x), a2 = bflo(w.y), a3 = bfhi(w.y), a4 = bflo(w.z), a5 = bfhi(w.z), a6 = bflo(w.w), a7 = bfhi(w.w);
        return ((a0 * a0 + a1 * a1) + (a2 * a2 + a3 * a3)) + ((a4 * a4 + a5 * a5) + (a6 * a6 + a7 * a7));
    }
    DEV void rowend(int rl, int wc, float ss) const {
        if (SS) { ss += __shfl_xor(ss, 16); ss += __shfl_xor(ss, 32); if ((threadIdx.x & 48) == 0) SS[(size_t)(row0 + rl) * 16 + ct * 2 + wc] = ss; }
    }
};
struct EpiQLds {
    static constexpr bool SYNC_EPI = true;
    unsigned char* q; const float* ss16; float mul; int row0;
    DEV float rowscale(int rl) const {
        const f32x4* s = (const f32x4*)(ss16 + (size_t)(row0 + rl) * 16); f32x4 a = s[0], b = s[1], c = s[2], d = s[3];
        const float t = ((a[0] + a[1]) + (a[2] + a[3])) + ((b[0] + b[1]) + (b[2] + b[3])) + ((c[0] + c[1]) + (c[2] + c[3])) + ((d[0] + d[1]) + (d[2] + d[3]));
        return rsqrtf(t * (1.f / D) + EPS) * mul;
    }
    DEV f32x4 pre(int, int) const { return (f32x4){0.f, 0.f, 0.f, 0.f}; }
    DEV float store8(int rl, int cl, f32x4 v0, f32x4 v1, float rs, f32x4, f32x4) const { *(u32x4*)(q + rl * 272 + cl * 2) = pk8(v0 * rs, v1 * rs); return 0.f; }
    DEV void rowend(int, int, float) const {}
};
struct EpiMoeUp {
    static constexpr bool SYNC_EPI = false;
    unsigned char* HB; const float* rstd2; const int* list; int nvalid; int slot0; int col0;
    DEV void rowscales(int rl0, float (&rs)[4]) const {
        int li[4];
#pragma unroll
        for (int m = 0; m < 4; ++m) li[m] = list[min(rl0 + 16 * m, nvalid - 1)];
#pragma unroll
        for (int m = 0; m < 4; ++m) rs[m] = rstd2[li[m] >> 1] * (1.f / F8_WSCALE);
    }
    DEV f32x4 pre(int, int) const { return (f32x4){0.f, 0.f, 0.f, 0.f}; }
    DEV float store8x2(int rl, int cl, f32x4 g0, f32x4 g1, f32x4 u0, f32x4 u1, float rs) const {
        f32x4 h0, h1;
#pragma unroll
        for (int i = 0; i < 4; ++i) { h0[i] = siluf_(g0[i] * rs) * (u0[i] * rs) * F8_HSCALE; h1[i] = siluf_(g1[i] * rs) * (u1[i] * rs) * F8_HSCALE; }
        const int row = slot0 + rl, col = col0 + cl;
        u32x2 q; q.x = pk4_f8(h0[0], h0[1], h0[2], h0[3]); q.y = pk4_f8(h1[0], h1[1], h1[2], h1[3]);
        *(u32x2*)(HB + ((size_t)((row >> 4) * 8 + (col >> 6)) * 1024 + ((col >> 4) & 3) * 256 + (row & 15) * 16 + (col & 15))) = q;
        return 0.f;
    }
    DEV float store8(int, int, f32x4, f32x4, float, f32x4, f32x4) const { return 0.f; }
    DEV void rowscales2(int rl0, float (&rs)[2]) const {
        int li[2];
#pragma unroll
        for (int m = 0; m < 2; ++m) li[m] = list[min(rl0 + 32 * m, nvalid - 1)];
#pragma unroll
        for (int m = 0; m < 2; ++m) rs[m] = rstd2[li[m] >> 1] * (1.f / F8_WSCALE);
    }
    DEV void store16(int rl, int cl, const f32x16& g, const f32x16& u, float rs) const {
        float h[16];
#pragma unroll
        for (int j = 0; j < 16; ++j) h[j] = siluf_(g[j] * rs) * (u[j] * rs) * F8_HSCALE;
        const int row = slot0 + rl, col = col0 + cl;
        u32x4 q; q.x = pk4_f8(h[0], h[1], h[2], h[3]); q.y = pk4_f8(h[4], h[5], h[6], h[7]); q.z = pk4_f8(h[8], h[9], h[10], h[11]); q.w = pk4_f8(h[12], h[13], h[14], h[15]);
        *(u32x4*)(HB + ((size_t)((row >> 7) * 8 + (col >> 6)) * 8192 + (row & 127) * 64 + ((col >> 4) & 3) * 16)) = q;
    }
    DEV void rowend(int, int, float) const {}
};
struct EpiMoeDown {
    static constexpr bool SYNC_EPI = false;
    unsigned char* Y; const float* gates; const int* list; int nvalid; int slot0; int col0;
    DEV void rowscales(int rl0, float (&rs)[4]) const {
        int li[4];
#pragma unroll
        for (int m = 0; m < 4; ++m) li[m] = list[min(rl0 + 16 * m, nvalid - 1)];
#pragma unroll
        for (int m = 0; m < 4; ++m) { const float g = gates[li[m]]; rs[m] = (rl0 + 16 * m < nvalid) ? g * (F8_HSCALE / (F8_WSCALE * F8_HSCALE)) : 0.f; }
    }
    DEV f32x4 pre(int, int) const { return (f32x4){0.f, 0.f, 0.f, 0.f}; }
    DEV float store8(int rl, int cl, f32x4 v0, f32x4 v1, float rs, f32x4, f32x4) const {
        v0 = v0 * rs; v1 = v1 * rs;
        u32x2 q; q.x = pk4_f8(v0[0], v0[1], v0[2], v0[3]); q.y = pk4_f8(v1[0], v1[1], v1[2], v1[3]);
        *(u32x2*)(Y + (size_t)(slot0 + rl) * D + col0 + cl) = q;
        return 0.f;
    }
    DEV void rowscales2(int rl0, float (&rs)[2]) const {
        int li[2];
#pragma unroll
        for (int m = 0; m < 2; ++m) li[m] = list[min(rl0 + 32 * m, nvalid - 1)];
#pragma unroll
        for (int m = 0; m < 2; ++m) { const float g = gates[li[m]]; rs[m] = (rl0 + 32 * m < nvalid) ? g * (F8_HSCALE / (F8_WSCALE * F8_HSCALE)) : 0.f; }
    }
    DEV void store16(int rl, int cl, const f32x16& v, const f32x16&, float rs) const {
        u32x4 q; q.x = pk4_f8(v[0] * rs, v[1] * rs, v[2] * rs, v[3] * rs); q.y = pk4_f8(v[4] * rs, v[5] * rs, v[6] * rs, v[7] * rs);
        q.z = pk4_f8(v[8] * rs, v[9] * rs, v[10] * rs, v[11] * rs); q.w = pk4_f8(v[12] * rs, v[13] * rs, v[14] * rs, v[15] * rs);
        *(u32x4*)(Y + (size_t)(slot0 + rl) * D + col0 + cl) = q;
    }
    DEV void rowend(int, int, float) const {}
};

struct Ctx {
    const Params* p; unsigned char* ws; unsigned char* lds;
    int tid, lane, wave, vb, G;
};
#define WSP(T, off) ((T*)(c.ws + (off)))

DEV int perm_row_inv(int c) { const int c1 = c & 63, c2 = c1 & 31, n = ((c1 >> 5) << 1) | ((c2 >> 2) & 1), i = ((c2 >> 3) << 2) | (c2 & 3); return (c & 64) + n * 16 + i; }
template <bool HAS_GAIN>
DEV void transpose_item_t(const float* W, int K, int N, int nblk, bf16_t* WT, const float* gain, float* scr, int item, int lane, int tm = 0, unsigned trmask = 0u) {
    const int kb = item / nblk, nb = item - kb * nblk, k0 = 64 * kb, n0 = 32 * nb;
    const int n = n0 + (lane & 31), nc = (n < N) ? n : (N - 1);
    const float* src = W + (size_t)(k0 + (lane >> 5)) * N + nc;
    float v[32];
#pragma unroll
    for (int i = 0; i < 32; ++i) v[i] = __builtin_nontemporal_load(src + (size_t)(2 * i) * N);
    if (HAS_GAIN) {
#pragma unroll
        for (int i = 0; i < 32; ++i) v[i] *= gain[k0 + 2 * i + (lane >> 5)];
    }
#pragma unroll
    for (int i = 0; i < 32; ++i) scr[(2 * i + (lane >> 5)) * 33 + (lane & 31)] = (n < N) ? v[i] : 0.f;
    LDS_FENCE();
    const int cc = lane & 7;
#pragma unroll
    for (int j = 0; j < 4; ++j) {
        const int nn = (lane >> 3) + 8 * j; const float* s = scr + (8 * cc) * 33 + nn;
        u32x4 o; o.x = pk2(s[0 * 33], s[1 * 33]); o.y = pk2(s[2 * 33], s[3 * 33]); o.z = pk2(s[4 * 33], s[5 * 33]); o.w = pk2(s[6 * 33], s[7 * 33]);
        size_t off = (size_t)(n0 + nn) * K + k0 + 8 * cc;
        if (tm) { const int n2 = n0 + nn, ct = n2 >> 7, cl = n2 & 127, sl = ((trmask >> ct) & 1u) ? cl : perm_row_inv(cl), k = k0 + 8 * cc;
                  off = ((size_t)(ct * (K >> 5) + (k >> 5)) * 128 + sl) * 32 + (k & 31); }
        *(u32x4*)(WT + off) = o;
    }
    LDS_FENCE();
}
DEV void transpose_item(const float* W, int K, int N, int nblk, bf16_t* WT, const float* gain, float* scr, int item, int lane, int tm = 0, unsigned trmask = 0u) {
    if (gain) transpose_item_t<true>(W, K, N, nblk, WT, gain, scr, item, lane, tm, trmask);
    else transpose_item_t<false>(W, K, N, nblk, WT, gain, scr, item, lane, tm, trmask);
}
DEV int perm_row64_inv(int c) { const int c2 = c & 31; return (c & 32) + ((c2 >> 2) & 1) * 16 + ((c2 >> 3) << 2) + (c2 & 3); }
template <bool HAS_GAIN, int TM>
DEV void transpose_item_f8(const float* W, int K, int N, int nblk, unsigned char* WT, const float* gain, float* scr, int item, int lane) {
    const int kb = item / nblk, nb = item - kb * nblk, k0 = 64 * kb, n0 = 32 * nb;
    const float* src = W + (size_t)(k0 + (lane >> 5)) * N + n0 + (lane & 31);
    float v[32];
#pragma unroll
    for (int i = 0; i < 32; ++i) v[i] = __builtin_nontemporal_load(src + (size_t)(2 * i) * N);
#pragma unroll
    for (int i = 0; i < 32; ++i) scr[(2 * i + (lane >> 5)) * 33 + (lane & 31)] = v[i] * (HAS_GAIN ? gain[k0 + 2 * i + (lane >> 5)] * F8_WSCALE : F8_WSCALE);
    LDS_FENCE();
    const int cc = lane & 7;
#pragma unroll
    for (int j = 0; j < 4; ++j) {
        const int nn = (lane >> 3) + 8 * j; const float* s = scr + (8 * cc) * 33 + nn;
        u32x2 o; o.x = pk4_f8(s[0 * 33], s[1 * 33], s[2 * 33], s[3 * 33]); o.y = pk4_f8(s[4 * 33], s[5 * 33], s[6 * 33], s[7 * 33]);
        const int n2 = n0 + nn;
        size_t off;
        if (TM == 1)      off = ((size_t)(((n2 >> 6) * (K >> 7) + (k0 >> 7)) * 2 + ((k0 >> 6) & 1)) * 64 + perm_row64_inv(n2 & 63)) * 64 + 8 * cc;
        else if (TM == 4) off = (((size_t)(n2 >> 8) * (K >> 6) + (k0 >> 6)) * 256 + (n2 & 224) + perm32_inv(n2 & 31)) * 64 + 8 * cc;
        else if (TM == 3) off = ((size_t)(((n2 >> 7) * (K >> 7) + (k0 >> 7)) * 2 + ((k0 >> 6) & 1)) * 128 + (n2 & 96) + perm32_inv(n2 & 31)) * 64 + 8 * cc;
        else if (TM == 2) off = ((size_t)(((n2 >> 7) * (K >> 7) + (k0 >> 7)) * 2 + ((k0 >> 6) & 1)) * 128 + perm_row_inv(n2 & 127)) * 64 + 8 * cc;
        else              off = (size_t)n2 * K + k0 + 8 * cc;
        __builtin_nontemporal_store(o, (u32x2*)(WT + off));
    }
    LDS_FENCE();
}
DEV void row_to_bf16(const float* xrow, bf16_t* orow, float* rstd_out, int lane) {
    const f32x4* xr = (const f32x4*)xrow + lane;
    f32x4 v[2][4];
#pragma unroll
    for (int r = 0; r < 2; ++r)
#pragma unroll
        for (int j = 0; j < 4; ++j) v[r][j] = __builtin_nontemporal_load(xr + r * (D / 4) + 64 * j);
#pragma unroll
    for (int r = 0; r < 2; ++r) {
        float s = 0.f;
#pragma unroll
        for (int j = 0; j < 4; ++j) s += (v[r][j][0] * v[r][j][0] + v[r][j][1] * v[r][j][1]) + (v[r][j][2] * v[r][j][2] + v[r][j][3] * v[r][j][3]);
        s = wave_sum(s);
        u32x2* o8 = (u32x2*)(orow + (size_t)r * D) + lane;
#pragma unroll
        for (int j = 0; j < 4; ++j) o8[64 * j] = pk4(v[r][j]);
        if (lane == 0) rstd_out[r] = rsqrtf(s * (1.f / D) + EPS);
    }
}

DEV void rowgroup_half_to_frag(const float* x, int g, int half, bf16_t* dstF, float* ss, int lane) {
    const int fr = lane & 15, fq = lane >> 4;
    const float* src = x + (size_t)(g * 16 + fr) * D + half * 512 + fq * 8;
    bf16_t* dst = dstF + ((size_t)(g * 32 + half * 16) * 64 + lane) * 8;
    float s = 0.f;
#pragma unroll
    for (int cb = 0; cb < 16; cb += 8) {
        f32x4 v[8][2];
#pragma unroll
        for (int c2 = 0; c2 < 8; ++c2) { v[c2][0] = __builtin_nontemporal_load((const f32x4*)(src + (cb + c2) * 32)); v[c2][1] = __builtin_nontemporal_load((const f32x4*)(src + (cb + c2) * 32 + 4)); }
#pragma unroll
        for (int c2 = 0; c2 < 8; ++c2) {
            const f32x4 a = v[c2][0], b = v[c2][1];
            s += ((a[0] * a[0] + a[1] * a[1]) + (a[2] * a[2] + a[3] * a[3])) + ((b[0] * b[0] + b[1] * b[1]) + (b[2] * b[2] + b[3] * b[3]));
            *(u32x4*)(dst + (size_t)(cb + c2) * 512) = pk8(a, b);
        }
    }
    s += __shfl_xor(s, 16); s += __shfl_xor(s, 32);
    if (fq == 0) atomicAdd(ss + g * 16 + fr, s);
}
DEV void rowpair_to_frag(const float* xrow, int row, bf16_t* dstF, float* ss_out, int lane) {
    const f32x4* xr = (const f32x4*)xrow + lane;
    f32x4 v[2][4];
#pragma unroll
    for (int r = 0; r < 2; ++r)
#pragma unroll
        for (int j = 0; j < 4; ++j) v[r][j] = __builtin_nontemporal_load(xr + r * (D / 4) + 64 * j);
#pragma unroll
    for (int r = 0; r < 2; ++r) {
        float s = 0.f;
#pragma unroll
        for (int j = 0; j < 4; ++j) s += (v[r][j][0] * v[r][j][0] + v[r][j][1] * v[r][j][1]) + (v[r][j][2] * v[r][j][2] + v[r][j][3] * v[r][j][3]);
        s = wave_sum(s);
#pragma unroll
        for (int j = 0; j < 4; ++j) *(u32x2*)(dstF + frag16_off(row + r, (64 * j + lane) * 4, 32)) = pk4(v[r][j]);
        if (lane == 0) ss_out[r] = s;
    }
}

DEV void phase_prologue(const Ctx& c) {
    const Params& p = *c.p;
    float* scr = (float*)(c.lds + c.wave * 8704);
    const int gw = c.vb * 4 + c.wave, NGW = c.G * 4;
    constexpr int I_IN = 16 * 92, I_OUT = 16 * 32, I_CQ = 16 * 16, I_CKV = 16 * 32, I_CO = 8 * 32;
    constexpr int NITEMS = I_IN + I_OUT + I_CQ + I_CKV + I_CO;
    constexpr int NROWP = MEMROWS / 2, NHG = (M / 16) * 2;
#pragma unroll 1
    for (int u = gw; u < NHG; u += NGW) {
        const int g = u >> 1, half = u & 1;
        bf16_t* dstF = (g < 512) ? WSP(bf16_t, WS_XB0FA) : (WSP(bf16_t, WS_XB0FB) - (size_t)512 * 32 * 512);
        rowgroup_half_to_frag(p.in[I_X], g, half, dstF, WSP(float, WS_RSTD0), c.lane);
    }
#pragma unroll 1
    for (int it = gw; it < NITEMS + NROWP; it += NGW) {
        if (it >= NITEMS) {
            const int r = (it - NITEMS) * 2;
            rowpair_to_frag(p.in[I_MEM] + (size_t)r * D, r, WSP(bf16_t, WS_MEMBF), WSP(float, WS_RSTDM) + r, c.lane);
            continue;
        }
        int r = it;
        if (r < I_IN) { transpose_item(p.in[I_W_IN], D, IN_COLS, 92, WSP(bf16_t, WS_WINT), p.in[I_NORM_MIX], scr, r, c.lane, 1, (1u << 5) | (0xFu << 14)); continue; } r -= I_IN;
        if (r < I_OUT) { transpose_item(p.in[I_W_OUT], D, D, 32, WSP(bf16_t, WS_WOUTT), (r < 8 * 32) ? p.in[I_NORM_ATT] : nullptr, scr, r, c.lane, 1, 0u); continue; } r -= I_OUT;
        if (r < I_CQ) { transpose_item(p.in[I_W_CQ], D, 512, 16, WSP(bf16_t, WS_WCQT), p.in[I_NORM_CROSS], scr, r, c.lane, 1, 0u); continue; } r -= I_CQ;
        if (r < I_CKV) { transpose_item(p.in[I_W_CKV], D, D, 32, WSP(bf16_t, WS_WCKVT), p.in[I_NORM_MEM], scr, r, c.lane, 1, 0xF0u); continue; } r -= I_CKV;
        transpose_item(p.in[I_W_CO], 512, D, 32, WSP(bf16_t, WS_WCOT), nullptr, scr, r, c.lane, 1, 0u);
    }
    for (int e = c.vb * 256 + c.tid; e < 48 * D; e += c.G * 256) {
        const int ci = e >> 10, k = e & 1023;
        float w = 0.f;
        if (ci < 36) w = ((ci < 4) ? p.in[I_W_RG][k * 4 + ci] : p.in[I_W_RE][k * 32 + (ci - 4)]) * p.in[I_NORM_FFN][k];
        const unsigned hi = f2bf(w);
        const size_t fo = frag16_off(ci, k, 32);
        WSP(bf16_t, WS_WRH)[fo] = (bf16_t)hi; WSP(bf16_t, WS_WRL)[fo] = (bf16_t)f2bf(w - bf2f(hi));
    }
}

constexpr int CONV_TOTAL = NEXP * 768, CONV_QUOTA = 2;
DEV void expert_convert_round(const Ctx& c, int round) {
    const Params& p = *c.p;
    float* scr = (float*)(c.lds + c.wave * 8704);
    const int it = round * (c.G * 4) + c.vb * 4 + c.wave;
    if (it < CONV_TOTAL) {
        const int e = it / 768; int r = it - e * 768;
        if (r < 256) transpose_item_f8<true, 3>(p.in[I_W_EG] + (size_t)e * D * DEXP, D, DEXP, 16, WSP(unsigned char, WS_WGT) + (size_t)e * DEXP * D, p.in[I_NORM_FFN], scr, r, c.lane);
        else if (r < 512) transpose_item_f8<true, 3>(p.in[I_W_EU] + (size_t)e * D * DEXP, D, DEXP, 16, WSP(unsigned char, WS_WUT) + (size_t)e * DEXP * D, p.in[I_NORM_FFN], scr, r - 256, c.lane);
        else transpose_item_f8<false, 4>(p.in[I_W_ED] + (size_t)e * DEXP * D, DEXP, D, 32, WSP(unsigned char, WS_WDT) + (size_t)e * D * DEXP, nullptr, scr, r - 512, c.lane);
    }
}
DEV void expert_convert_rest(const Ctx& c, int& conv_done) {
    while (conv_done * (c.G * 4) < CONV_TOTAL) { expert_convert_round(c, conv_done); ++conv_done; }
    __syncthreads();
}
DEV void xcd_barrier_work(const XcdBarrier& b, const Ctx& c, int& conv_done, int quota) {
    asm volatile("s_waitcnt vmcnt(0)" ::: "memory");
    __syncthreads();
    if (threadIdx.x == 0) {
        unsigned* bar = b.bar;
        __builtin_amdgcn_s_waitcnt(0);
        unsigned nloc = b.st[0], nx = b.st[1];
        if (nloc == 0u) { xcd_barrier_complete(bar, b.x, nloc, nx); b.st[0] = nloc; b.st[1] = nx; }
        const unsigned old = xb_add(&bar[XB_XSUB(b.x)], 1u);
        const unsigned gen = old / nloc;
        asm volatile("buffer_inv sc1" ::: "memory");
        b.st[2] = (old + 1u == (gen + 1u) * nloc) ? 1u : 0u;
        b.st[3] = gen;
    }
    __syncthreads();
    const bool leader = b.st[2] != 0u;
    if (!leader) { for (int q = 0; q < quota && conv_done * (c.G * 4) < CONV_TOTAL; ++q) { expert_convert_round(c, conv_done); ++conv_done; } }
    if (threadIdx.x == 0) {
        unsigned* bar = b.bar;
        const unsigned nx = b.st[1], gen = b.st[3];
        if (leader) {
            __builtin_amdgcn_fence(__ATOMIC_RELEASE, "agent");
            asm volatile("s_waitcnt vmcnt(0)" ::: "memory");
            const unsigned og = xb_add(&bar[XB_TOP], 1u);
            const unsigned tg = og / nx;
            if (og + 1u == (tg + 1u) * nx) xb_add(&bar[XB_TOPGEN], 1u);
            else XB_SPIN(xb_ld(&bar[XB_TOPGEN]) == tg, bar);
            xb_add(&bar[XB_XGEN(b.x)], 1u);
            asm volatile("s_waitcnt vmcnt(0)" ::: "memory");
        } else {
            XB_SPIN(xb_ld(&bar[XB_XGEN(b.x)]) == gen, bar);
            asm volatile("s_waitcnt vmcnt(0)" ::: "memory");
        }
    }
    __syncthreads();
}

DEV void phase_inproj(const Ctx& c) {
    const Params& p = *c.p;
    const int tid = c.tid, sr = tid >> 2, sc = (tid & 3) * 8;
    constexpr int NT_MAIN = 64 * 23, NT = NT_MAIN + 32;
    for (int id = c.vb; id < NT; id += c.G) {
        int rb, ct, kind;
        const bf16_t* A; const bf16_t* Bt; const float* rs; bf16_t* out; int ld = 0, lay = 0, act = 0, col0 = 0, hs = 7, nh = 4, sshift = 12; float mul = 1.f;
        if (id < NT_MAIN) {
            const int grp = id / (4 * 23), rem = id - grp * (4 * 23); ct = rem >> 2; rb = grp * 4 + (rem & 3);
            A = (rb < 32) ? WSP(bf16_t, WS_XB0FA) : (WSP(bf16_t, WS_XB0FB) - (size_t)512 * 32 * 512); Bt = WSP(bf16_t, WS_WINT); rs = WSP(float, WS_RSTD0);
            if (ct < 4)        { kind = 0; out = WSP(bf16_t, WS_QA); ld = 512; lay = 1; mul = 0.125f; col0 = ct * 128; }
            else if (ct == 4)  { kind = 0; out = WSP(bf16_t, WS_KA); ld = 128; lay = 1; }
            else if (ct == 5)  { kind = 1; out = WSP(bf16_t, WS_VAT); hs = 6; nh = 2; }
            else if (ct < 14)  { kind = 0; out = WSP(bf16_t, WS_QKR); ld = 1024; col0 = (ct - 6) * 128; }
            else if (ct < 18)  { kind = 1; out = WSP(bf16_t, WS_VMT); col0 = (ct - 14) * 128; }
            else if (ct < 22)  { kind = 0; out = WSP(bf16_t, WS_OM); ld = 512; lay = 1; act = 1; col0 = (ct - 18) * 128; }
            else               { kind = 2; out = nullptr; }
        } else {
            const int k = id - NT_MAIN; rb = k >> 3; ct = k & 7;
            A = WSP(bf16_t, WS_MEMBF); Bt = WSP(bf16_t, WS_WCKVT); rs = WSP(float, WS_RSTDM);
            if (ct < 4) { kind = 0; out = WSP(bf16_t, WS_KMEM); ld = 512; lay = 1; col0 = ct * 128; }
            else        { kind = 1; out = WSP(bf16_t, WS_VMEMT); col0 = (ct - 4) * 128; sshift = 8; }
        }
        const int row0 = rb * 256;
        const bf16_t* A0 = A + (size_t)((row0 >> 4) + (tid >> 6)) * 32 * 512 + (tid & 63) * 8;
        const bf16_t* Ar[4] = { A0, A0 + (size_t)4 * 32 * 512, A0 + (size_t)8 * 32 * 512, A0 + (size_t)12 * 32 * 512 };
        const bf16_t* B0 = Bt + ((size_t)ct * 32 * 128 + sr) * 32 + sc;
        const bf16_t* Br[1][2] = { { B0, B0 + 64 * 32 } };
        if (kind == 0)      { EpiRowBf16 e{out, ld, rs, nullptr, mul, act, row0, col0, lay}; gemm_tile<1, 8, false, false, true>(c.lds, Ar, Br, D, e, -1, 512, 4096); }
        else if (kind == 1) { EpiTrans e{out, rs, row0, col0, hs, nh, sshift}; gemm_tile<1, 8, true, false, true>(c.lds, Ar, Br, D, e, -1, 512, 4096); }
        else                { EpiGates e{WSP(float, WS_G), rs, p.in[I_B_GATES], row0}; gemm_tile<1, 8, false, false, true>(c.lds, Ar, Br, D, e, -1, 512, 4096); }
    }
}

DEV void attn_item(const Ctx& c, int item) {
    const Params& p = *c.p;
    const int lane = c.lane, fr = lane & 15, fq = lane >> 4;
    const int b = item >> 9, qb = (item >> 1) & 255, kvh = item & 1, q0 = qb * 16, tok0 = b * SEQ + q0, kbase = (q0 - 128) & ~31;
    const bf16_t* QA = WSP(bf16_t, WS_QA); const bf16_t* KA = WSP(bf16_t, WS_KA); const bf16_t* VAT = WSP(bf16_t, WS_VAT);
    bf16_t* MIX = WSP(bf16_t, WS_MIX);
    float ssq = 0.f;
    const int t = q0 + fr;
#pragma unroll 1
    for (int g = 0; g < 4; ++g) {
        const int h = kvh * 4 + g;
        bf16x8 kf[10][2];
#pragma unroll
        for (int kt = 0; kt < 10; ++kt) {
            int ktile = (kbase >> 4) + kt; ktile = ktile < 0 ? 0 : (ktile > 255 ? 255 : ktile);
#pragma unroll
            for (int ks = 0; ks < 2; ++ks) kf[kt][ks] = *frag_ptr(KA, b * 256 + ktile, kvh * 2 + ks, 4, lane);
        }
        const float slope = exp2f(-(float)(h + 1)), sink = p.in[I_SINKS][h];
        const bf16x8 qf0 = __builtin_nontemporal_load(frag_ptr(QA, tok0 >> 4, h * 2, 16, lane)), qf1 = __builtin_nontemporal_load(frag_ptr(QA, tok0 >> 4, h * 2 + 1, 16, lane));
        __builtin_amdgcn_sched_barrier(0);
        f32x4 s[10];
#pragma unroll
        for (int kt = 0; kt < 10; ++kt) {
            f32x4 acc = {0.f, 0.f, 0.f, 0.f};
            acc = mfma16(kf[kt][0], qf0, acc); acc = mfma16(kf[kt][1], qf1, acc);
            s[kt] = acc;
        }
        float mx = sink;
#pragma unroll
        for (int kt = 0; kt < 10; ++kt)
#pragma unroll
            for (int r = 0; r < 4; ++r) {
                const int key = kbase + kt * 16 + 4 * fq + r, dist = t - key;
                const bool valid = (key >= 0) && (dist >= 0) && (dist < 128);
                const float l = valid ? s[kt][r] - slope * (float)dist : -INFINITY;
                s[kt][r] = l; mx = fmaxf(mx, l);
            }
        mx = fmaxf(mx, __shfl_xor(mx, 16)); mx = fmaxf(mx, __shfl_xor(mx, 32));
        float sum = 0.f;
#pragma unroll
        for (int kt = 0; kt < 10; ++kt)
#pragma unroll
            for (int r = 0; r < 4; ++r) { const float e = __expf(s[kt][r] - mx); s[kt][r] = e; sum += e; }
        sum += __shfl_xor(sum, 16); sum += __shfl_xor(sum, 32);
        const float inv = 1.f / (sum + __expf(sink - mx));
        bf16x8 pf[5];
#pragma unroll
        for (int i = 0; i < 5; ++i) pf[i] = frag_from(pk4(s[2 * i] * inv), pk4(s[2 * i + 1] * inv));
#pragma unroll
        for (int dg = 0; dg < 2; ++dg) {
            bf16x8 vf[2][5];
#pragma unroll
            for (int u = 0; u < 2; ++u)
#pragma unroll
                for (int i = 0; i < 5; ++i) { int i32 = (kbase >> 5) + i; i32 = i32 < 0 ? 0 : (i32 > 127 ? 127 : i32); vf[u][i] = *frag_ptr(VAT, (b * 2 + kvh) * 4 + dg * 2 + u, i32, 128, lane); }
            __builtin_amdgcn_sched_barrier(0);
#pragma unroll
            for (int u = 0; u < 2; ++u) {
                const int dt = dg * 2 + u;
                f32x4 acc = {0.f, 0.f, 0.f, 0.f};
#pragma unroll
                for (int i = 0; i < 5; ++i) acc = mfma16(vf[u][i], pf[i], acc);
                const u32x2 w = pk4(acc);
                *(u32x2*)(MIX + frag16_off(tok0 + fr, h * 64 + dt * 16 + 4 * fq, 32)) = w;
                const float a0 = bflo(w.x), a1 = bfhi(w.x), a2 = bflo(w.y), a3 = bfhi(w.y);
                ssq += (a0 * a0 + a1 * a1) + (a2 * a2 + a3 * a3);
            }
        }
    }
    ssq += __shfl_xor(ssq, 16); ssq += __shfl_xor(ssq, 32);
    if (fq == 0) WSP(float, WS_ATTSS)[(size_t)(tok0 + fr) * 2 + kvh] = ssq;
}

DEV void conv4x8(const bf16_t* raw, int seq_pos0, const float* cw, const float* cbias, int chn0, float (&out)[4][8]) {
    u32x4 rv[7];
#pragma unroll
    for (int i = 0; i < 7; ++i) {
        const bool ok = (seq_pos0 + i - 3) >= 0;
        rv[i] = *(const u32x4*)(raw + (ok ? (i - 3) : 0) * 1024);
        if (!ok) rv[i] = (u32x4){0u, 0u, 0u, 0u};
    }
    f32x4 w[4][2];
#pragma unroll
    for (int t = 0; t < 4; ++t) { w[t][0] = *(const f32x4*)(cw + t * 1024 + chn0); w[t][1] = *(const f32x4*)(cw + t * 1024 + chn0 + 4); }
    const f32x4 b0 = *(const f32x4*)(cbias + chn0), b1 = *(const f32x4*)(cbias + chn0 + 4);
    float x[7][8];
#pragma unroll
    for (int i = 0; i < 7; ++i)
#pragma unroll
        for (int j = 0; j < 4; ++j) { x[i][2 * j] = bflo(rv[i][j]); x[i][2 * j + 1] = bfhi(rv[i][j]); }
#pragma unroll
    for (int r = 0; r < 4; ++r)
#pragma unroll
        for (int j = 0; j < 8; ++j) {
            float o = (j < 4) ? b0[j & 3] : b1[j & 3];
#pragma unroll
            for (int t = 0; t < 4; ++t) o += ((j < 4) ? w[t][0][j & 3] : w[t][1][j & 3]) * x[r + t][j];
            out[r][j] = siluf_(o);
        }
}
DEV void mlstm_a_item(const Ctx& c, int item) {
    const Params& p = *c.p;
    const int tid = c.tid, lane = c.lane, wave = c.wave, fr = lane & 15, fq = lane >> 4;
    const int bh = item >> 6, ch = item & 63, b = bh >> 2, h = bh & 3, tokc = b * SEQ + ch * 64;
    bf16_t* KwT = (bf16_t*)c.lds;
    float* wsc = (float*)(c.lds + 18432);
    float* unp = (float*)(c.lds + 18432 + 256);
    const float* G = WSP(float, WS_G);
    float ig = 0.f, lf = 0.f;
    if (wave == 0) { ig = G[(size_t)(tokc + lane) * 8 + h]; lf = G[(size_t)(tokc + lane) * 8 + 4 + h]; }
    bf16x8 vfr[2][2];
#pragma unroll
    for (int ks = 0; ks < 2; ++ks)
#pragma unroll
        for (int a = 0; a < 2; ++a) vfr[ks][a] = *frag_ptr(WSP(bf16_t, WS_VMT), bh * 8 + 2 * wave + a, ch * 2 + ks, 128, lane);
    const int cg = tid & 15, rg = tid >> 4, s0 = 4 * rg, chn0 = 512 + h * 128 + 8 * cg;
    float kv[4][8];
    conv4x8(WSP(bf16_t, WS_QKR) + (size_t)(tokc + s0) * 1024 + chn0, ch * 64 + s0, p.in[I_CONV_W], p.in[I_CONV_B], chn0, kv);
    if (wave == 0) {
        float bcs = lf;
#pragma unroll
        for (int o = 1; o < 64; o <<= 1) { const float u = __shfl_up(bcs, o); if (lane >= o) bcs += u; }
        const float blast = __shfl(bcs, 63);
        const float logw = blast - bcs + ig;
        const float mloc = wave_max(logw);
        wsc[lane] = __expf(logw - mloc);
        if (lane == 0) { float* sc = WSP(float, WS_SC) + (size_t)item * 2; sc[0] = blast; sc[1] = mloc; }
    }
    __syncthreads();
    {
        const float w0 = wsc[s0] * 0.08838834764831845f, w1 = wsc[s0 + 1] * 0.08838834764831845f, w2 = wsc[s0 + 2] * 0.08838834764831845f, w3 = wsc[s0 + 3] * 0.08838834764831845f;
#pragma unroll
        for (int j = 0; j < 8; ++j) {
            f32x4 kw; kw[0] = kv[0][j] * w0; kw[1] = kv[1][j] * w1; kw[2] = kv[2][j] * w2; kw[3] = kv[3][j] * w3;
            *(u32x2*)(KwT + (8 * cg + j) * 72 + s0) = pk4(kw);
            float un = (kw[0] + kw[1]) + (kw[2] + kw[3]);
            un += __shfl_xor(un, 16); un += __shfl_xor(un, 32);
            if (lane < 16) unp[wave * 128 + 8 * cg + j] = un;
        }
    }
    __syncthreads();
    if (tid < 128) WSP(float, WS_UN)[(size_t)item * 128 + tid] = (unp[tid] + unp[128 + tid]) + (unp[256 + tid] + unp[384 + tid]);
    {
        const bf16_t* VMT = WSP(bf16_t, WS_VMT);
        f32x4 acc[2][8];
#pragma unroll
        for (int a = 0; a < 2; ++a)
#pragma unroll
            for (int n = 0; n < 8; ++n) acc[a][n] = (f32x4){0.f, 0.f, 0.f, 0.f};
#pragma unroll
        for (int ks = 0; ks < 2; ++ks) {
#pragma unroll
            for (int n = 0; n < 8; ++n) {
                const bf16_t* kr = KwT + (n * 16 + fr) * 72 + ks * 32 + 4 * fq;
                const bf16x8 kk = frag_from(*(const u32x2*)kr, *(const u32x2*)(kr + 16));
#pragma unroll
                for (int a = 0; a < 2; ++a) acc[a][n] = mfma16(kk, vfr[ks][a], acc[a][n]);
            }
        }
        bf16_t* UT = ((bf16_t*)c.p->out) + (size_t)item * 16384;
#pragma unroll
        for (int a = 0; a < 2; ++a)
#pragma unroll
            for (int n = 0; n < 8; ++n) *(u32x2*)(UT + frag16_off((2 * wave + a) * 16 + fr, n * 16 + 4 * fq, 4)) = pk4(acc[a][n]);
    }
    __syncthreads();
}

DEV void attn_block_item(const Ctx& c, int item) {
    const Params& p = *c.p;
    const int tid = c.tid, lane = c.lane, fr = lane & 15, fq = lane >> 4, wave = c.wave;
    const int b = item >> 7, qb64 = (item >> 1) & 63, kvh = item & 1, q0b = qb64 * 64;
    const int kbaseB = min(max(q0b - 128, 0), SEQ - 224);
    const bf16_t* QA = WSP(bf16_t, WS_QA); const bf16_t* KA = WSP(bf16_t, WS_KA); const bf16_t* VAT = WSP(bf16_t, WS_VAT);
    bf16_t* MIX = WSP(bf16_t, WS_MIX);
    unsigned char* ldsK = c.lds; unsigned char* ldsV = c.lds + 28672;
#pragma unroll
    for (int j = 0; j < 7; ++j) {
        const int q = tid + 256 * j;
        __builtin_amdgcn_global_load_lds((const unsigned*)(KA + ((size_t)((b * 256 + (kbaseB >> 4) + (q >> 7)) * 4 + kvh * 2) * 64 + (q & 127)) * 8), (LAS unsigned*)(ldsK + q * 16), 16, 0, 0);
        const int dt = q / 448, wi = q - dt * 448;
        __builtin_amdgcn_global_load_lds((const unsigned*)(VAT + ((size_t)(((b * 2 + kvh) * 4 + dt) * 128 + (kbaseB >> 5)) * 64 + wi) * 8), (LAS unsigned*)(ldsV + q * 16), 16, 0, 0);
    }
    const int q0 = q0b + 16 * wave, tok0 = b * SEQ + q0, t = q0 + fr;
    const int kbase = min(max((q0 - 128) & ~31, 0), SEQ - 160);
    const unsigned char* kw0 = ldsK + ((kbase - kbaseB) >> 4) * 2048; const unsigned char* vw0 = ldsV + ((kbase - kbaseB) >> 5) * 1024;
    bf16x8 qf0 = __builtin_nontemporal_load(frag_ptr(QA, tok0 >> 4, kvh * 8, 16, lane)), qf1 = __builtin_nontemporal_load(frag_ptr(QA, tok0 >> 4, kvh * 8 + 1, 16, lane));
    asm volatile("s_waitcnt vmcnt(0)" ::: "memory");
    __syncthreads();
    float ssq = 0.f;
#pragma unroll 1
    for (int g = 0; g < 4; ++g) {
        const int h = kvh * 4 + g;
        const float slope = exp2f(-(float)(h + 1)), sink = p.in[I_SINKS][h];
        int oz = 0; asm volatile("" : "+s"(oz));
        const unsigned char* kw = kw0 + oz; const unsigned char* vw = vw0 + oz;
        f32x4 s[10];
#pragma unroll
        for (int kt = 0; kt < 10; ++kt) {
            f32x4 acc = {0.f, 0.f, 0.f, 0.f};
            acc = mfma16(*(const bf16x8*)(kw + (kt * 2) * 1024 + lane * 16), qf0, acc); acc = mfma16(*(const bf16x8*)(kw + (kt * 2 + 1) * 1024 + lane * 16), qf1, acc);
            s[kt] = acc;
        }
        if (g < 3) { qf0 = __builtin_nontemporal_load(frag_ptr(QA, tok0 >> 4, (h + 1) * 2, 16, lane)); qf1 = __builtin_nontemporal_load(frag_ptr(QA, tok0 >> 4, (h + 1) * 2 + 1, 16, lane)); }
        float mx = sink;
#pragma unroll
        for (int kt = 0; kt < 10; ++kt)
#pragma unroll
            for (int r = 0; r < 4; ++r) {
                const int key = kbase + kt * 16 + 4 * fq + r, dist = t - key;
                const bool valid = (key >= 0) && (dist >= 0) && (dist < 128);
                const float l = valid ? s[kt][r] - slope * (float)dist : -INFINITY;
                s[kt][r] = l; mx = fmaxf(mx, l);
            }
        mx = fmaxf(mx, __shfl_xor(mx, 16)); mx = fmaxf(mx, __shfl_xor(mx, 32));
        float sum = 0.f;
#pragma unroll
        for (int kt = 0; kt < 10; ++kt)
#pragma unroll
            for (int r = 0; r < 4; ++r) { const float e = __expf(s[kt][r] - mx); s[kt][r] = e; sum += e; }
        sum += __shfl_xor(sum, 16); sum += __shfl_xor(sum, 32);
        const float inv = 1.f / (sum + __expf(sink - mx));
        bf16x8 pf[5];
#pragma unroll
        for (int i = 0; i < 5; ++i) pf[i] = frag_from(pk4(s[2 * i] * inv), pk4(s[2 * i + 1] * inv));
#pragma unroll
        for (int dt = 0; dt < 4; ++dt) {
            f32x4 acc = {0.f, 0.f, 0.f, 0.f};
#pragma unroll
            for (int i = 0; i < 5; ++i) acc = mfma16(*(const bf16x8*)(vw + (dt * 7 + i) * 1024 + lane * 16), pf[i], acc);
            const u32x2 w = pk4(acc);
            *(u32x2*)(MIX + frag16_off(tok0 + fr, h * 64 + dt * 16 + 4 * fq, 32)) = w;
            const float a0 = bflo(w.x), a1 = bfhi(w.x), a2 = bflo(w.y), a3 = bfhi(w.y);
            ssq += (a0 * a0 + a1 * a1) + (a2 * a2 + a3 * a3);
        }
    }
    ssq += __shfl_xor(ssq, 16); ssq += __shfl_xor(ssq, 32);
    if (fq == 0) WSP(float, WS_ATTSS)[(size_t)(tok0 + fr) * 2 + kvh] = ssq;
    __syncthreads();
}

DEV void phase_mix_a(const Ctx& c) {
    const bool attn_first = false;
    if (attn_first) { for (int item = c.vb; item < 512; item += c.G) attn_block_item(c, item); }
    for (int item = c.vb; item < 1024; item += c.G) mlstm_a_item(c, item);
    if (!attn_first) { for (int item = c.vb; item < 512; item += c.G) attn_block_item(c, item); }
}

DEV void phase_mlstm_scan(const Ctx& c) {
    float* dec = (float*)c.lds; float* inj = dec + 64; float* mpv = dec + 128;
    const int tid = c.tid;
    for (int item = (int)blockIdx.x; item < 16 * 17; item += c.G) {
        const int bh = item / 17, sl = item - bh * 17;
        if (c.wave == 0) {
            const float* sc = WSP(float, WS_SC) + (size_t)bh * 64 * 2;
            const int lane = c.lane;
            const float bl = sc[2 * lane], ml = sc[2 * lane + 1];
            float A = ml, B = bl;
#pragma unroll
            for (int o = 1; o < 64; o <<= 1) {
                const float Ap = __shfl_up(A, o), Bp = __shfl_up(B, o);
                if (lane >= o) { A = fmaxf(A, B + Ap); B = B + Bp; }
            }
            const float mcur = fmaxf(A, B + 0.f);
            float mprev = __shfl_up(mcur, 1); if (lane == 0) mprev = 0.f;
            dec[lane] = __expf(bl + mprev - mcur); inj[lane] = __expf(ml - mcur); mpv[lane] = mprev;
        }
        __syncthreads();
        if (sl < 16) {
            if (tid < 128) {
                const bf16_t* UT = ((const bf16_t*)c.p->out) + (size_t)bh * 64 * 16384 + sl * 1024 + tid * 8;
                bf16_t* CP = ((bf16_t*)c.p->out) + (size_t)1024 * 16384 + (size_t)bh * 64 * 16384 + sl * 1024 + tid * 8;
                f32x4 s0 = {0.f, 0.f, 0.f, 0.f}, s1 = {0.f, 0.f, 0.f, 0.f};
#pragma unroll 16
                for (int k = 0; k < 64; ++k) {
                    const u32x4 u = __builtin_nontemporal_load((const u32x4*)(UT + (size_t)k * 16384));
                    *(u32x4*)(CP + (size_t)k * 16384) = pk8(s0, s1);
                    f32x4 u0, u1; u0[0] = bflo(u.x); u0[1] = bfhi(u.x); u0[2] = bflo(u.y); u0[3] = bfhi(u.y); u1[0] = bflo(u.z); u1[1] = bfhi(u.z); u1[2] = bflo(u.w); u1[3] = bfhi(u.w);
                    s0 = s0 * dec[k] + u0 * inj[k]; s1 = s1 * dec[k] + u1 * inj[k];
                }
            }
        } else {
            if (tid < 128) {
                const float* UN = WSP(float, WS_UN) + (size_t)bh * 64 * 128 + tid;
                float* NP = WSP(float, WS_NP) + (size_t)bh * 64 * 128 + tid;
                float s0 = 0.f;
#pragma unroll 8
                for (int k = 0; k < 64; ++k) { const float u0 = UN[k * 128]; NP[k * 128] = s0; s0 = dec[k] * s0 + inj[k] * u0; }
            } else if (tid < 192) {
                WSP(float, WS_MP)[bh * 64 + (tid - 128)] = mpv[tid - 128];
            }
        }
        __syncthreads();
    }
}

DEV void mlstm_c_item(const Ctx& c, int item) {
    const Params& p = *c.p;
    const int tid = c.tid, lane = c.lane, wave = c.wave, fr = lane & 15, fq = lane >> 4;
    const int bh = item >> 6, ch = item & 63, b = bh >> 2, h = bh & 3, tokc = b * SEQ + ch * 64;
    bf16_t* Qs = (bf16_t*)c.lds;
    bf16_t* Ks = (bf16_t*)(c.lds + 17408);
    float* a_s = (float*)(c.lds + 34816);
    float* Mt  = a_s + 64;
    float* ain = a_s + 128;
    float* en  = a_s + 192;
    float* npv = a_s + 256;
    const float* G = WSP(float, WS_G);
    float ig = 0.f, lf = 0.f, mprev = 0.f, np0 = 0.f, np1 = 0.f;
    if (wave == 0) { ig = G[(size_t)(tokc + lane) * 8 + h]; lf = G[(size_t)(tokc + lane) * 8 + 4 + h]; mprev = WSP(float, WS_MP)[item]; }
    else if (wave == 1) { const float* NP = WSP(float, WS_NP) + (size_t)item * 128; np0 = NP[lane]; np1 = NP[64 + lane]; }
    const bf16_t* VMT = WSP(bf16_t, WS_VMT);
    const bf16_t* CP = ((const bf16_t*)c.p->out) + (size_t)1024 * 16384 + (size_t)item * 16384;
    const bf16_t* OM = WSP(bf16_t, WS_OM);
    bf16x8 vfr[4][2], cfr[4][4]; u32x2 ow[4];
#pragma unroll
    for (int u = 0; u < 4; ++u) {
#pragma unroll
        for (int i = 0; i < 2; ++i) vfr[u][i] = __builtin_nontemporal_load(frag_ptr(VMT, bh * 8 + u, ch * 2 + i, 128, lane));
        ow[u] = __builtin_nontemporal_load((const u32x2*)(OM + frag16_off(tokc + wave * 16 + fr, h * 128 + u * 16 + 4 * fq, 16)));
    }
    __builtin_amdgcn_sched_barrier(0);
    {
        const int cg = tid & 15, rg = tid >> 4, s0 = 4 * rg;
        float v[4][8];
        {
            const int chn0 = h * 128 + 8 * cg;
            conv4x8(WSP(bf16_t, WS_QKR) + (size_t)(tokc + s0) * 1024 + chn0, ch * 64 + s0, p.in[I_CONV_W], p.in[I_CONV_B], chn0, v);
#pragma unroll
            for (int r = 0; r < 4; ++r) { u32x4 o; o.x = pk2(v[r][0], v[r][1]); o.y = pk2(v[r][2], v[r][3]); o.z = pk2(v[r][4], v[r][5]); o.w = pk2(v[r][6], v[r][7]);
                                          *(u32x4*)(Qs + (s0 + r) * 136 + 8 * cg) = o; }
        }
        {
            const int chn0 = 512 + h * 128 + 8 * cg; const float sc = 0.08838834764831845f;
            conv4x8(WSP(bf16_t, WS_QKR) + (size_t)(tokc + s0) * 1024 + chn0, ch * 64 + s0, p.in[I_CONV_W], p.in[I_CONV_B], chn0, v);
#pragma unroll
            for (int r = 0; r < 4; ++r) { u32x4 o; o.x = pk2(v[r][0] * sc, v[r][1] * sc); o.y = pk2(v[r][2] * sc, v[r][3] * sc); o.z = pk2(v[r][4] * sc, v[r][5] * sc); o.w = pk2(v[r][6] * sc, v[r][7] * sc);
                                          *(u32x4*)(Ks + (s0 + r) * 136 + 8 * cg) = o; }
        }
    }
#pragma unroll
    for (int u = 0; u < 4; ++u)
#pragma unroll
        for (int ks = 0; ks < 4; ++ks) cfr[u][ks] = __builtin_nontemporal_load(frag_ptr(CP, u, ks, 4, lane));
    __builtin_amdgcn_sched_barrier(0);
    if (wave == 0) {
        float bcs = lf;
#pragma unroll
        for (int o = 1; o < 64; o <<= 1) { const float u = __shfl_up(bcs, o); if (lane >= o) bcs += u; }
        const float a = ig - bcs;
        float pm = a;
#pragma unroll
        for (int o = 1; o < 64; o <<= 1) { const float u = __shfl_up(pm, o); if (lane >= o) pm = fmaxf(pm, u); }
        const float mt = fmaxf(mprev, pm);
        a_s[lane] = a; Mt[lane] = mt; ain[lane] = __expf(mprev - mt); en[lane] = __expf(-(bcs + mt));
    } else if (wave == 1) { npv[lane] = np0; npv[64 + lane] = np1; }
    __syncthreads();
    {
        const int t = wave * 16 + fr;
        bf16x8 qf[4];
#pragma unroll
        for (int ks = 0; ks < 4; ++ks) qf[ks] = *(const bf16x8*)(Qs + t * 136 + ks * 32 + 8 * fq);
        const float mt = Mt[t];
        f32x4 pt[4]; float dl = 0.f;
#pragma unroll
        for (int st = 0; st < 4; ++st) {
            f32x4 acc = {0.f, 0.f, 0.f, 0.f};
            if (st <= wave) {
#pragma unroll
                for (int ks = 0; ks < 4; ++ks) acc = mfma16(*(const bf16x8*)(Ks + (st * 16 + fr) * 136 + ks * 32 + 8 * fq), qf[ks], acc);
#pragma unroll
                for (int r = 0; r < 4; ++r) {
                    const int s = st * 16 + 4 * fq + r;
                    const float v = (s <= t) ? acc[r] * __expf(a_s[s] - mt) : 0.f;
                    const float vr = bflo(pk2(v, 0.f));
                    acc[r] = vr; dl += vr;
                }
            }
            pt[st] = acc;
        }
        dl += __shfl_xor(dl, 16); dl += __shfl_xor(dl, 32);
        float dn = 0.f;
#pragma unroll
        for (int j = 0; j < 32; ++j) dn += bf2f(Qs[t * 136 + 32 * fq + j]) * npv[32 * fq + j];
        dn += __shfl_xor(dn, 16); dn += __shfl_xor(dn, 32);
        const float ai = ain[t];
        const float den = dl + ai * dn;
        const float invd = 1.f / fmaxf(fabsf(den), en[t]);
        bf16x8 pf[2];
#pragma unroll
        for (int i = 0; i < 2; ++i) pf[i] = frag_from(pk4(pt[2 * i]), pk4(pt[2 * i + 1]));
        f32x4 hv[8]; float ssq = 0.f;
#pragma unroll
        for (int dg = 0; dg < 2; ++dg) {
            if (dg == 1) {
#pragma unroll
                for (int u = 0; u < 4; ++u) {
                    const int dvt = 4 + u;
#pragma unroll
                    for (int i = 0; i < 2; ++i) vfr[u][i] = __builtin_nontemporal_load(frag_ptr(VMT, bh * 8 + dvt, ch * 2 + i, 128, lane));
#pragma unroll
                    for (int ks = 0; ks < 4; ++ks) cfr[u][ks] = __builtin_nontemporal_load(frag_ptr(CP, dvt, ks, 4, lane));
                    ow[u] = __builtin_nontemporal_load((const u32x2*)(OM + frag16_off(tokc + wave * 16 + fr, h * 128 + dvt * 16 + 4 * fq, 16)));
                }
            }
            __builtin_amdgcn_sched_barrier(0);
#pragma unroll
            for (int u = 0; u < 4; ++u) {
                f32x4 apv = {0.f, 0.f, 0.f, 0.f}, aqc = {0.f, 0.f, 0.f, 0.f};
#pragma unroll
                for (int i = 0; i < 2; ++i) apv = mfma16(vfr[u][i], pf[i], apv);
#pragma unroll
                for (int ks = 0; ks < 4; ++ks) aqc = mfma16(cfr[u][ks], qf[ks], aqc);
                f32x4 hh = (apv + aqc * ai) * invd;
                hh[0] *= bflo(ow[u].x); hh[1] *= bfhi(ow[u].x); hh[2] *= bflo(ow[u].y); hh[3] *= bfhi(ow[u].y);
                hv[dg * 4 + u] = hh; ssq += (hh[0] * hh[0] + hh[1] * hh[1]) + (hh[2] * hh[2] + hh[3] * hh[3]);
            }
        }
        ssq += __shfl_xor(ssq, 16); ssq += __shfl_xor(ssq, 32);
        const float rstd = rsqrtf(ssq * (1.f / 128.f) + EPS);
        const float* g = p.in[I_NORM_ML] + h * 128;
        bf16_t* MIX = WSP(bf16_t, WS_MIX);
#pragma unroll
        for (int dvt = 0; dvt < 8; ++dvt) {
            const f32x4 gg = *(const f32x4*)(g + dvt * 16 + 4 * fq);
            *(u32x2*)(MIX + frag16_off(tokc + t, 512 + h * 128 + dvt * 16 + 4 * fq, 32)) = pk4(hv[dvt] * rstd * gg);
        }
    }
    __syncthreads();
}
DEV void phase_mlstm_c(const Ctx& c) {
    for (int item = c.vb; item < 1024; item += c.G) mlstm_c_item(c, item);
}

DEV void phase_outproj(const Ctx& c) {
    const Params& p = *c.p; const int tid = c.tid, sr = tid >> 2, sc = (tid & 3) * 8;
    for (int id = c.vb; id < 64 * 8; id += c.G) {
        const int grp = id >> 5, rem = id & 31, ct = rem >> 2, rb = grp * 4 + (rem & 3), row0 = rb * 256;
        const bf16_t* A = WSP(bf16_t, WS_MIX) + (size_t)((row0 >> 4) + (tid >> 6)) * 32 * 512 + (tid & 63) * 8; const bf16_t* Bt = WSP(bf16_t, WS_WOUTT);
        const bf16_t* Ar[4] = { A, A + (size_t)4 * 32 * 512, A + (size_t)8 * 32 * 512, A + (size_t)12 * 32 * 512 };
        const bf16_t* B0 = Bt + ((size_t)ct * 32 * 128 + sr) * 32 + sc;
        const bf16_t* Br[1][2] = { { B0, B0 + 64 * 32 } };
        bf16_t* XF = (rb < 32) ? WSP(bf16_t, WS_XB0FA) : (WSP(bf16_t, WS_XB0FB) - (size_t)512 * 32 * 512);
        EpiResid e{nullptr, nullptr, nullptr, WSP(float, WS_SS1), WSP(float, WS_ATTSS), nullptr, row0, ct * 128, ct, XF, XF};
        gemm_tile<1, 8, false, true, true>(c.lds, Ar, Br, D, e, 16, 512, 4096);
    }
}
DEV void cross_item2(const Ctx& c, int tt, int h, const unsigned char* qlds) {
    const int lane = c.lane, fr = lane & 15, fq = lane >> 4;
    const int tok0 = tt * 16, b = tok0 >> 12;
    const bf16_t* KM = WSP(bf16_t, WS_KMEM); const bf16_t* VT = WSP(bf16_t, WS_VMEMT);
    bf16x8 qf[2][4];
#pragma unroll
    for (int u = 0; u < 2; ++u)
#pragma unroll
        for (int ks = 0; ks < 4; ++ks) qf[u][ks] = *(const bf16x8*)(qlds + (u * 16 + fr) * 272 + (ks * 32 + 8 * fq) * 2);
    f32x4 s[2][16];
    bf16x8 kf[2][2][4];
#pragma unroll
    for (int v = 0; v < 2; ++v)
#pragma unroll
        for (int ks = 0; ks < 4; ++ks) kf[0][v][ks] = *frag_ptr(KM, b * 16 + v, h * 4 + ks, 16, lane);
#pragma unroll
    for (int sg = 0; sg < 8; ++sg) {
        if (sg + 1 < 8) {
#pragma unroll
            for (int v = 0; v < 2; ++v)
#pragma unroll
                for (int ks = 0; ks < 4; ++ks) kf[(sg + 1) & 1][v][ks] = *frag_ptr(KM, b * 16 + (sg + 1) * 2 + v, h * 4 + ks, 16, lane);
        }
        __builtin_amdgcn_sched_barrier(0);
#pragma unroll
        for (int v = 0; v < 2; ++v)
#pragma unroll
            for (int u = 0; u < 2; ++u) {
                f32x4 acc = {0.f, 0.f, 0.f, 0.f};
#pragma unroll
                for (int ks = 0; ks < 4; ++ks) acc = mfma16(kf[sg & 1][v][ks], qf[u][ks], acc);
                s[u][sg * 2 + v] = acc;
            }
        __builtin_amdgcn_sched_barrier(0);
    }
    bf16x8 pf[2][8];
#pragma unroll
    for (int u = 0; u < 2; ++u) {
        float mx = -INFINITY;
#pragma unroll
        for (int st = 0; st < 16; ++st)
#pragma unroll
            for (int r = 0; r < 4; ++r) mx = fmaxf(mx, s[u][st][r]);
        mx = fmaxf(mx, __shfl_xor(mx, 16)); mx = fmaxf(mx, __shfl_xor(mx, 32));
        float sum = 0.f;
#pragma unroll
        for (int st = 0; st < 16; ++st)
#pragma unroll
            for (int r = 0; r < 4; ++r) { const float e = __expf(s[u][st][r] - mx); s[u][st][r] = e; sum += e; }
        sum += __shfl_xor(sum, 16); sum += __shfl_xor(sum, 32);
        const float inv = __builtin_amdgcn_rcpf(sum);
#pragma unroll
        for (int i = 0; i < 8; ++i) pf[u][i] = frag_from(pk4(s[u][2 * i] * inv), pk4(s[u][2 * i + 1] * inv));
    }
    bf16_t* O = WSP(bf16_t, WS_O);
    bf16x8 vfr[2][8];
#pragma unroll
    for (int i = 0; i < 8; ++i) vfr[0][i] = *frag_ptr(VT, (b * 4 + h) * 8, i, 8, lane);
#pragma unroll
    for (int dt = 0; dt < 8; ++dt) {
        if (dt + 1 < 8) {
#pragma unroll
            for (int i = 0; i < 8; ++i) vfr[(dt + 1) & 1][i] = *frag_ptr(VT, (b * 4 + h) * 8 + dt + 1, i, 8, lane);
        }
        __builtin_amdgcn_sched_barrier(0);
#pragma unroll
        for (int u = 0; u < 2; ++u) {
            f32x4 acc = {0.f, 0.f, 0.f, 0.f};
#pragma unroll
            for (int i = 0; i < 8; ++i) acc = mfma16(vfr[dt & 1][i], pf[u][i], acc);
            *(u32x2*)(O + frag16_off(tok0 + u * 16 + fr, h * 128 + dt * 16 + 4 * fq, 16)) = pk4(acc);
        }
        __builtin_amdgcn_sched_barrier(0);
    }
}
#define RAW_BARRIER() asm volatile("s_waitcnt lgkmcnt(0)\n\ts_barrier" ::: "memory")
DEV void cross_block(const Ctx& c, int rb, int h) {
    const int tid = c.tid, lane = c.lane, fr = lane & 15, fq = lane >> 4, wave = c.wave;
    const int tok0 = (rb * 8 + 2 * wave) * 16, b = (rb * 128) >> 12;
    const bf16_t* KM = WSP(bf16_t, WS_KMEM); const bf16_t* VT = WSP(bf16_t, WS_VMEMT);
    unsigned char* h0 = c.lds; unsigned char* h1 = c.lds + 32768;
    const unsigned char* qlds = c.lds + 32768 + (2 * wave) * 16 * 272;
#define CROSS_DMA_K(half_, dst_) do { _Pragma("unroll") for (int j = 0; j < 8; ++j) { const int q = tid + 256 * j; \
        __builtin_amdgcn_global_load_lds((const unsigned*)(KM + ((size_t)((b * 16 + (half_) * 8 + (q >> 8)) * 16 + h * 4) * 64 + (q & 255)) * 8), (LAS unsigned*)((dst_) + q * 16), 16, 0, 0); } } while (0)
#define CROSS_DMA_V(half_, dst_) do { _Pragma("unroll") for (int j = 0; j < 8; ++j) { const int q = tid + 256 * j; \
        __builtin_amdgcn_global_load_lds((const unsigned*)(VT + ((size_t)(((b * 4 + h) * 8 + (half_) * 4) * 8) * 64 + q) * 8), (LAS unsigned*)((dst_) + q * 16), 16, 0, 0); } } while (0)
    CROSS_DMA_K(0, h0);
    RAW_BARRIER();
    bf16x8 qf[2][4];
#pragma unroll
    for (int u = 0; u < 2; ++u)
#pragma unroll
        for (int ks = 0; ks < 4; ++ks) qf[u][ks] = *(const bf16x8*)(qlds + (u * 16 + fr) * 272 + (ks * 32 + 8 * fq) * 2);
    RAW_BARRIER();
    CROSS_DMA_K(1, h1);
    f32x4 s[2][16];
#pragma unroll
    for (int half = 0; half < 2; ++half) {
        if (half == 0) asm volatile("s_waitcnt vmcnt(8)" ::: "memory"); else asm volatile("s_waitcnt vmcnt(0)" ::: "memory");
        RAW_BARRIER();
        const unsigned char* kb = half ? h1 : h0;
#pragma unroll
        for (int rg = 0; rg < 8; ++rg) {
            bf16x8 kf[4];
#pragma unroll
            for (int ks = 0; ks < 4; ++ks) kf[ks] = *(const bf16x8*)(kb + (rg * 4 + ks) * 1024 + lane * 16);
#pragma unroll
            for (int u = 0; u < 2; ++u) {
                f32x4 acc = {0.f, 0.f, 0.f, 0.f};
#pragma unroll
                for (int ks = 0; ks < 4; ++ks) acc = mfma16(kf[ks], qf[u][ks], acc);
                s[u][half * 8 + rg] = acc;
            }
        }
    }
    bf16x8 pf[2][8];
#pragma unroll
    for (int u = 0; u < 2; ++u) {
        float mx = -INFINITY;
#pragma unroll
        for (int st = 0; st < 16; ++st)
#pragma unroll
            for (int r = 0; r < 4; ++r) mx = fmaxf(mx, s[u][st][r]);
        mx = fmaxf(mx, __shfl_xor(mx, 16)); mx = fmaxf(mx, __shfl_xor(mx, 32));
        float sum = 0.f;
#pragma unroll
        for (int st = 0; st < 16; ++st)
#pragma unroll
            for (int r = 0; r < 4; ++r) { const float e = __expf(s[u][st][r] - mx); s[u][st][r] = e; sum += e; }
        sum += __shfl_xor(sum, 16); sum += __shfl_xor(sum, 32);
        const float inv = __builtin_amdgcn_rcpf(sum);
#pragma unroll
        for (int i = 0; i < 8; ++i) pf[u][i] = frag_from(pk4(s[u][2 * i] * inv), pk4(s[u][2 * i + 1] * inv));
    }
    RAW_BARRIER();
    CROSS_DMA_V(0, h0); CROSS_DMA_V(1, h1);
    u32x2 ov[8][2];
#pragma unroll
    for (int half = 0; half < 2; ++half) {
        if (half == 0) asm volatile("s_waitcnt vmcnt(8)" ::: "memory"); else asm volatile("s_waitcnt vmcnt(0)" ::: "memory");
        RAW_BARRIER();
        const unsigned char* vb = half ? h1 : h0;
#pragma unroll
        for (int d4 = 0; d4 < 4; ++d4) {
            bf16x8 vf[8];
#pragma unroll
            for (int i = 0; i < 8; ++i) vf[i] = *(const bf16x8*)(vb + (d4 * 8 + i) * 1024 + lane * 16);
#pragma unroll
            for (int u = 0; u < 2; ++u) {
                f32x4 acc = {0.f, 0.f, 0.f, 0.f};
#pragma unroll
                for (int i = 0; i < 8; ++i) acc = mfma16(vf[i], pf[u][i], acc);
                ov[half * 4 + d4][u] = pk4(acc);
            }
        }
    }
    bf16_t* O = WSP(bf16_t, WS_O);
#pragma unroll
    for (int dt = 0; dt < 8; ++dt)
#pragma unroll
        for (int u = 0; u < 2; ++u) *(u32x2*)(O + frag16_off(tok0 + u * 16 + fr, h * 128 + dt * 16 + 4 * fq, 16)) = ov[dt][u];
#undef CROSS_DMA_K
#undef CROSS_DMA_V
}
DEV void phase_crossqa(const Ctx& c) {
    const int tid = c.tid, sr = tid >> 2, sc = (tid & 3) * 8;
    for (int id = c.vb; id < 128 * 4; id += c.G) {
        const int grp = id >> 5, rem = id & 31, h = rem >> 3, rb = grp * 8 + (rem & 7), row0 = rb * 128;
        const bf16_t* AF = (row0 < 8192) ? WSP(bf16_t, WS_XB0FA) : (WSP(bf16_t, WS_XB0FB) - (size_t)512 * 32 * 512); const bf16_t* Bt = WSP(bf16_t, WS_WCQT);
        const bf16_t* A0 = AF + (size_t)((row0 >> 4) + (tid >> 6)) * 32 * 512 + (tid & 63) * 8;
        const bf16_t* Ar[2] = { A0, A0 + (size_t)4 * 32 * 512 };
        const bf16_t* B0 = Bt + ((size_t)h * 32 * 128 + sr) * 32 + sc;
        const bf16_t* Br[1][2] = { { B0, B0 + 64 * 32 } };
        EpiQLds e{c.lds + 32768, WSP(float, WS_SS1), 0.08838834764831845f, row0};
        gemm_tile<1, 4, false, false, true>(c.lds, Ar, Br, D, e, -1, 512, 4096);
        cross_block(c, rb, h);
        __syncthreads();
    }
}
DEV void phase_crossout(const Ctx& c) {
    const Params& p = *c.p; const int tid = c.tid, sr = tid >> 2, sc = (tid & 3) * 8;
    for (int id = c.vb; id < 64 * 8; id += c.G) {
        const int grp = id >> 5, rem = id & 31, ct = rem >> 2, rb = grp * 4 + (rem & 3), row0 = rb * 256;
        const bf16_t* A = WSP(bf16_t, WS_O) + (size_t)((row0 >> 4) + (tid >> 6)) * 16 * 512 + (tid & 63) * 8; const bf16_t* Bt = WSP(bf16_t, WS_WCOT);
        const bf16_t* Ar[4] = { A, A + (size_t)4 * 16 * 512, A + (size_t)8 * 16 * 512, A + (size_t)12 * 16 * 512 };
        const bf16_t* B0 = Bt + ((size_t)ct * 16 * 128 + sr) * 32 + sc;
        const bf16_t* Br[1][2] = { { B0, B0 + 64 * 32 } };
        EpiResid e{nullptr, nullptr, WSP(bf16_t, WS_XB), nullptr, nullptr, (unsigned char*)p.out, row0, ct * 128, ct, (rb < 32) ? WSP(bf16_t, WS_XB0FA) : (WSP(bf16_t, WS_XB0FB) - (size_t)512 * 32 * 512)};
        gemm_tile<1, 8, false, false, true>(c.lds, Ar, Br, 512, e, -1, 512, 4096);
    }
}

DEV void phase_route(const Ctx& c, unsigned* cnt, int* list, float* gates_o, float* rstd2_o) {
    const Params& p = *c.p;
    const int lane = c.lane, fr = lane & 15, fq = lane >> 4, wave = c.wave;
    const bf16_t* WH0 = WSP(bf16_t, WS_WRH); const bf16_t* WL0 = WSP(bf16_t, WS_WRL);
    float* redg[2] = { (float*)c.lds, (float*)(c.lds + 13312) };
    float* lgg[2]  = { (float*)(c.lds + 26624), (float*)(c.lds + 26624 + 3328) };
    int* sel = (int*)(c.lds + 33280);
    int nit = 0;
#pragma unroll 1
    for (int o0 = 0; c.vb + o0 * c.G < M / 16; o0 += 2) {
        int oz = 0; asm volatile("" : "+s"(oz));
        const bf16_t* WH = WH0 + oz; const bf16_t* WL = WL0 + oz;
        const int itA = c.vb + o0 * c.G, itB = itA + c.G;
        const bool validB = itB < M / 16;
        const int tokA = itA * 16, tokB = (validB ? itB : itA) * 16;
        bf16x8 xv[2][8];
        {
            const bf16_t* xa = WSP(bf16_t, WS_XB) + (size_t)(tokA + fr) * D + wave * 256 + 8 * fq;
            const bf16_t* xb = WSP(bf16_t, WS_XB) + (size_t)(tokB + fr) * D + wave * 256 + 8 * fq;
#pragma unroll
            for (int ks = 0; ks < 8; ++ks) { xv[0][ks] = *(const bf16x8*)(xa + ks * 32); xv[1][ks] = *(const bf16x8*)(xb + ks * 32); }
        }
        f32x4 acc[2][3]; float ssq[2] = {0.f, 0.f};
#pragma unroll
        for (int g = 0; g < 2; ++g)
#pragma unroll
            for (int nt = 0; nt < 3; ++nt) acc[g][nt] = (f32x4){0.f, 0.f, 0.f, 0.f};
#pragma unroll
        for (int kp = 0; kp < 4; ++kp) {
            bf16x8 wa[2][3], wb[2][3];
#pragma unroll
            for (int u = 0; u < 2; ++u)
#pragma unroll
                for (int nt = 0; nt < 3; ++nt) { wa[u][nt] = *frag_ptr(WH, nt, wave * 8 + 2 * kp + u, 32, lane); wb[u][nt] = *frag_ptr(WL, nt, wave * 8 + 2 * kp + u, 32, lane); }
            __builtin_amdgcn_sched_barrier(0);
#pragma unroll
            for (int u = 0; u < 2; ++u)
#pragma unroll
                for (int g = 0; g < 2; ++g) {
                    const bf16x8 xh = xv[g][2 * kp + u];
                    const u32x4 xw = __builtin_bit_cast(u32x4, xh);
#pragma unroll
                    for (int j = 0; j < 4; ++j) { const float a = bflo(xw[j]), b2 = bfhi(xw[j]); ssq[g] += a * a + b2 * b2; }
#pragma unroll
                    for (int nt = 0; nt < 3; ++nt) { acc[g][nt] = mfma16(wa[u][nt], xh, acc[g][nt]); acc[g][nt] = mfma16(wb[u][nt], xh, acc[g][nt]); }
                }
            __builtin_amdgcn_sched_barrier(0);
        }
#pragma unroll
        for (int g = 0; g < 2; ++g) {
            float sq = ssq[g];
            sq += __shfl_xor(sq, 16); sq += __shfl_xor(sq, 32);
            float* r = redg[g] + (wave * 64 + lane) * 13;
#pragma unroll
            for (int nt = 0; nt < 3; ++nt)
#pragma unroll
                for (int q = 0; q < 4; ++q) r[nt * 4 + q] = acc[g][nt][q];
            r[12] = sq;
        }
        __syncthreads();
        if (wave < 2 && (wave == 0 || validB)) {
            const float* red = redg[wave]; float* lg = lgg[wave];
            const int tok0 = wave ? tokB : tokA, ord = o0 + wave;
            float t[13];
#pragma unroll
            for (int q = 0; q < 13; ++q) t[q] = (red[lane * 13 + q] + red[(64 + lane) * 13 + q]) + (red[(128 + lane) * 13 + q] + red[(192 + lane) * 13 + q]);
            const float rs = rsqrtf(t[12] * (1.f / D) + EPS);
#pragma unroll
            for (int nt = 0; nt < 3; ++nt)
#pragma unroll
                for (int q = 0; q < 4; ++q) lg[fr * 52 + nt * 16 + 4 * fq + q] = t[nt * 4 + q] * rs;
            LDS_FENCE();
            if (lane < 16) {
                const float* l = lg + lane * 52;
                const float* bg = p.in[I_B_RG]; const float* be = p.in[I_B_RE];
                int gs = 0; float gm = l[0] + bg[0];
                for (int j = 1; j < 4; ++j) { const float v = l[j] + bg[j]; if (v > gm) { gm = v; gs = j; } }
                float gsum = 0.f;
                for (int j = 0; j < 4; ++j) gsum += __expf(l[j] + bg[j] - gm);
                const float gw_ = 1.f / gsum;
                int i1 = 0; float v1 = l[4 + gs * 8] + be[gs * 8];
                for (int j = 1; j < 8; ++j) { const float v = l[4 + gs * 8 + j] + be[gs * 8 + j]; if (v > v1) { v1 = v; i1 = j; } }
                int i2 = -1; float v2 = -INFINITY;
                for (int j = 0; j < 8; ++j) { const float v = l[4 + gs * 8 + j] + be[gs * 8 + j]; if (j != i1 && v > v2) { v2 = v; i2 = j; } }
                const float e2 = __expf(v2 - v1);
                const float p1 = gw_ / (1.f + e2), p2 = gw_ * e2 / (1.f + e2);
                const int tok = tok0 + lane;
                rstd2_o[tok] = rs;
                sel[ord * 32 + lane * 2] = gs * 8 + i1; sel[ord * 32 + lane * 2 + 1] = gs * 8 + i2;
                gates_o[tok * 2] = p1; gates_o[tok * 2 + 1] = p2;
            }
        }
        nit += validB ? 2 : 1;
        __syncthreads();
    }
    if (wave == 0) {
        const int na = nit * 32;
        for (int a0 = 0; a0 < na; a0 += 64) {
            const int a = a0 + lane;
            const int myexp = (a < na) ? sel[a] : -1;
            int rank = 0, mycount = 0;
#pragma unroll
            for (int e = 0; e < NEXP; ++e) {
                const unsigned long long m = __ballot(myexp == e);
                if (myexp == e) rank = __popcll(m & ((1ull << lane) - 1ull));
                if (lane == e) mycount = __popcll(m);
            }
            unsigned base = 0u;
            if (lane < NEXP && mycount > 0) base = atomicAdd(&cnt[lane * 64], (unsigned)mycount);
            const unsigned mybase = (unsigned)__shfl((int)base, myexp < 0 ? 0 : myexp);
            if (myexp >= 0) { const int tok = (c.vb + (a >> 5) * c.G) * 16 + ((a & 31) >> 1); list[(size_t)myexp * M + mybase + rank] = tok * 2 + (a & 1); }
        }
    }
    __syncthreads();
}

DEV int moe_table(const Ctx& c, int* rbstart) {
    const unsigned* cnt = WSP(unsigned, WS_CTL) + CW_CNT;
    if (c.tid == 0) { int acc = 0; for (int e = 0; e < NEXP; ++e) { const int n = (int)cnt[e * 64]; rbstart[e] = acc; rbstart[36 + e] = n; acc += (n + 127) >> 7; } rbstart[NEXP] = acc; }
    __syncthreads();
    const int R = rbstart[NEXP];
    unsigned char* rbexp = (unsigned char*)(rbstart + 68);
    for (int rbg = c.tid; rbg < R; rbg += 256) { int e = 0; for (int j = 1; j < NEXP; ++j) if (rbstart[j] <= rbg) e = j; rbexp[rbg] = (unsigned char)e; }
    __syncthreads();
    return R;
}
DEV void moe_up_unit(const Ctx& c, const int* rbstart, int id) {
    const Params& p = *c.p;
    const unsigned* cnt = WSP(unsigned, WS_CTL) + CW_CNT;
    const int tid = c.tid, sr = tid >> 2, sc = ((tid & 3) ^ ((tid >> 4) & 3)) * 8;
    const int rbg = id >> 2, ct = id & 3;
    const int e = ((const unsigned char*)(rbstart + 68))[rbg];
    const int rb = rbg - rbstart[e], ne = rbstart[36 + e], nvalid = min(128, ne - rb * 128);
    const int* list = WSP(int, WS_LIST) + (size_t)e * M + rb * 128;
    const int slot0 = rbg * 128;
    const int lt = list[min(tid & 127, nvalid - 1)], l0 = list[min(sr, nvalid - 1)], l1 = list[min(sr + 64, nvalid - 1)];
    if (ct == 0 && tid < nvalid) WSP(int, WS_SLOTOF)[lt] = slot0 + tid;
    const int t0 = (sr < nvalid) ? (l0 >> 1) : 0, t1 = (sr + 64 < nvalid) ? (l1 >> 1) : 0;
    const bf16_t* A = (const bf16_t*)p.out;
    const bf16_t* Bg = WSP(bf16_t, WS_WGT) + (size_t)e * DEXP * (D / 2); const bf16_t* Bu = WSP(bf16_t, WS_WUT) + (size_t)e * DEXP * (D / 2);
    const bf16_t* Ar[2] = { A + (size_t)t0 * (D / 2) + sc, A + (size_t)t1 * (D / 2) + sc };
    const bf16_t* Bg0 = Bg + (size_t)ct * 16 * 4096 + sr * 32 + sc; const bf16_t* Bu0 = Bu + (size_t)ct * 16 * 4096 + sr * 32 + sc;
    const bf16_t* Br[2][2] = { { Bg0, Bg0 + 2048 }, { Bu0, Bu0 + 2048 } };
    EpiMoeUp ep{WSP(unsigned char, WS_HB), WSP(float, WS_RSTD2), list, nvalid, slot0, ct * 128};
    gemm_tile_f8w<2, 2>(c.lds, Ar, Br, D / 2, ep, 32, 4096);
}
template <int NW>
DEV void moe_down_part(const Ctx& c, const int* rbstart, int pid) {
    constexpr int P = 4 / NW;
    const int tid = c.tid, sr = tid >> 2, sc = ((tid & 3) ^ ((tid >> 4) & 3)) * 8;
    const int id = pid / P, part = pid % P, rbg = id >> 2, ct = id & 3;
    const int e = ((const unsigned char*)(rbstart + 68))[rbg];
    const int rb = rbg - rbstart[e], ne = rbstart[36 + e], nvalid = min(128, ne - rb * 128);
    const int* list = WSP(int, WS_LIST) + (size_t)e * M + rb * 128;
    const int slot0 = rbg * 128;
    const bf16_t* A = WSP(bf16_t, WS_HB); const bf16_t* Bd = WSP(bf16_t, WS_WDT) + (size_t)e * D * (DEXP / 2);
    const bf16_t* A0 = A + (size_t)rbg * 8 * 4096 + sr * 32 + sc;
    const bf16_t* Ar[2] = { A0, A0 + 2048 };
    const bf16_t* B0 = Bd + (size_t)ct * 8 * 8192 + part * (NW * 2048) + sr * 32 + sc;
    const bf16_t* Br[1][NW];
#pragma unroll
    for (int i = 0; i < NW; ++i) Br[0][i] = B0 + i * 2048;
    EpiMoeDown ep{WSP(unsigned char, WS_Y), WSP(float, WS_GATES), list, nvalid, slot0, ct * 256 + part * (NW * 64)};
    gemm_tile_f8w<1, NW>(c.lds, Ar, Br, DEXP / 2, ep, 4096, 8192);
}
DEV void moe_down_spread(const Ctx& c, const int* rbstart, int j0, int L) {
    if (L <= 0) return;
    const int G = c.G;
    const int cf = ((L + G - 1) / G) * 40, ch = ((2 * L + G - 1) / G) * 21, cq = ((4 * L + G - 1) / G) * 12;
    const int sb = (G == 512) ? ((c.vb & 63) >> 2) * 32 + (c.vb >> 6) * 4 + (c.vb & 3) : c.vb;
    if (cq <= ch && cq <= cf)      { for (int j = 4 * j0 + sb; j < 4 * (j0 + L); j += G) moe_down_part<1>(c, rbstart, j); }
    else if (ch <= cf)             { for (int j = 2 * j0 + sb; j < 2 * (j0 + L); j += G) moe_down_part<2>(c, rbstart, j); }
    else                           { for (int j = j0 + sb; j < j0 + L; j += G) moe_down_part<4>(c, rbstart, j); }
}
constexpr int MOE_COMP = 2;
DEV void phase_moe_a(const Ctx& c) {
    int* rbstart = (int*)(c.lds + 73728);
    const int R = moe_table(c, rbstart), U = R * 4, full = (U / c.G) * c.G;
    for (int id = c.vb; id < full; id += c.G) moe_up_unit(c, rbstart, id);
}
DEV void phase_moe_b(const Ctx& c) {
    int* rbstart = (int*)(c.lds + 73728);
    const int R = moe_table(c, rbstart), U = R * 4, full = (U / c.G) * c.G, T = U - full, D1 = (full >> 2) * 4;
    bool is_up = c.vb < T; int upi = c.vb, dni = c.vb - T;
    if (c.G == 512) {
        const int x = c.vb >> 6, l = c.vb & 63, tq = T >> 3, tr = T & 7, tl = tq + (x < tr ? 1 : 0);
        is_up = l < tl; upi = l * 8 + x; dni = c.vb - (x * tq + min(x, tr)) - tl;
    }
    if (is_up) moe_up_unit(c, rbstart, full + upi);
    const int ncomp = min(D1, MOE_COMP * (c.G - T));
    if (!is_up) { for (int q = 0; q < MOE_COMP; ++q) { const int j = dni * MOE_COMP + q; if (j < ncomp) moe_down_part<4>(c, rbstart, j); } }
    const int fullr = ((D1 - ncomp) / c.G) * c.G;
    for (int j = ncomp + c.vb; j < ncomp + fullr; j += c.G) moe_down_part<4>(c, rbstart, j);
    moe_down_spread(c, rbstart, ncomp + fullr, D1 - ncomp - fullr);
}
DEV void phase_moe_c(const Ctx& c) {
    int* rbstart = (int*)(c.lds + 73728);
    const int R = moe_table(c, rbstart), U = R * 4, full = (U / c.G) * c.G, D1 = (full >> 2) * 4;
    moe_down_spread(c, rbstart, D1, R * 4 - D1);
}

DEV void phase_final(const Ctx& c, float* dst) {
    const Params& p = *c.p; const int lane = c.lane;
    const int gw = c.vb * 4 + c.wave, NGW = c.G * 4;
    const int* slotof = WSP(int, WS_SLOTOF); const unsigned char* Y = WSP(unsigned char, WS_Y);
    f32x4 gfin[4];
#pragma unroll
    for (int j = 0; j < 4; ++j) gfin[j] = ((const f32x4*)p.in[I_NORM_FINAL])[lane + 64 * j];
    int slots = 0;
    { const int tk = gw + (lane >> 1) * NGW; if (tk < M) slots = slotof[tk * 2 + (lane & 1)]; }
    int kit = 0;
    for (int tok = gw; tok < M; tok += NGW, ++kit) {
        int s0, s1;
        if (kit < 32) { s0 = __shfl(slots, 2 * kit); s1 = __shfl(slots, 2 * kit + 1); } else { s0 = slotof[tok * 2]; s1 = slotof[tok * 2 + 1]; }
        const u32x2* xr = (const u32x2*)(WSP(bf16_t, WS_XB) + (size_t)tok * D) + lane;
        const unsigned* y0 = (const unsigned*)(Y + (size_t)s0 * D) + lane; const unsigned* y1 = (const unsigned*)(Y + (size_t)s1 * D) + lane;
        f32x4 v[4]; float s = 0.f;
#pragma unroll
        for (int j = 0; j < 4; ++j) {
            const u32x2 xw = __builtin_nontemporal_load(xr + 64 * j); const unsigned a = __builtin_nontemporal_load(y0 + 64 * j), bq = __builtin_nontemporal_load(y1 + 64 * j);
            const float sc = 1.f / F8_HSCALE;
            v[j][0] = (bflo(xw.x) + __builtin_amdgcn_cvt_f32_fp8((int)a, 0) * sc) + __builtin_amdgcn_cvt_f32_fp8((int)bq, 0) * sc;
            v[j][1] = (bfhi(xw.x) + __builtin_amdgcn_cvt_f32_fp8((int)a, 1) * sc) + __builtin_amdgcn_cvt_f32_fp8((int)bq, 1) * sc;
            v[j][2] = (bflo(xw.y) + __builtin_amdgcn_cvt_f32_fp8((int)a, 2) * sc) + __builtin_amdgcn_cvt_f32_fp8((int)bq, 2) * sc;
            v[j][3] = (bfhi(xw.y) + __builtin_amdgcn_cvt_f32_fp8((int)a, 3) * sc) + __builtin_amdgcn_cvt_f32_fp8((int)bq, 3) * sc;
            s += (v[j][0] * v[j][0] + v[j][1] * v[j][1]) + (v[j][2] * v[j][2] + v[j][3] * v[j][3]);
        }
        const float rstd = rsqrtf(wave_sum(s) * (1.f / D) + EPS);
        f32x4* orow = (f32x4*)(dst + (size_t)tok * D) + lane;
#pragma unroll
        for (int j = 0; j < 4; ++j) __builtin_nontemporal_store(v[j] * rstd * gfin[j], orow + 64 * j);
    }
}

__global__ void __launch_bounds__(256, 2) mk_fwd(Params p) {
    __shared__ __attribute__((aligned(16))) unsigned char lds[LDS_BYTES];
    Ctx c; c.p = &p; c.ws = p.ws; c.lds = lds;
    c.tid = threadIdx.x; c.lane = c.tid & 63; c.wave = __builtin_amdgcn_readfirstlane(c.tid >> 6);
    c.G = gridDim.x; { const int bx = blockIdx.x; c.vb = (c.G % 8 == 0) ? (bx % 8) * (c.G / 8) + bx / 8 : bx; }
    volatile LAS unsigned* st = (volatile LAS unsigned*)(lds + LDS_ST_OFF);
    XcdBarrier bar; bar.bar = (unsigned*)p.ws + CW_BAR; bar.x = 0; bar.st = st;
    const bool multi = (p.ph_hi - p.ph_lo) > 1;
    if (multi) {
        if (c.tid < 4) st[c.tid] = 0u;
        __syncthreads();
        bar = xcd_barrier_post((unsigned*)p.ws + CW_BAR, st);
    }
    int conv_done = 0;
#define PH(k, call) do { if (p.ph_lo <= (k) && (k) < p.ph_hi) { if ((k) == 10) expert_convert_rest(c, conv_done); call; \
        if ((k) + 1 < p.ph_hi) { if ((k) < 10) xcd_barrier_work(bar, c, conv_done, CONV_QUOTA); else xcd_barrier(bar); } } } while (0)
    PH(0, phase_prologue(c));
    PH(1, phase_inproj(c));
    PH(2, phase_mix_a(c));
    PH(3, phase_mlstm_scan(c));
    PH(4, phase_mlstm_c(c));
    PH(6, phase_outproj(c));
    PH(7, phase_crossqa(c));
    PH(9, phase_crossout(c));
    PH(10, phase_route(c, WSP(unsigned, WS_CTL) + CW_CNT, WSP(int, WS_LIST), WSP(float, WS_GATES), WSP(float, WS_RSTD2)));
    PH(11, phase_moe_a(c));
    PH(12, phase_moe_b(c));
    PH(13, phase_moe_c(c));
    PH(14, phase_final(c, p.out));
#undef PH
}

extern "C" void kernel_launch(void* const* d_in, const int* in_sizes, int n_in, void* d_out, int out_size, void* d_ws, size_t ws_size, hipStream_t stream) {
    static int grid = 0;
    if (grid == 0) {
        if (n_in != N_IN || in_sizes[0] != M * D || out_size != M * D || ws_size < WS_END) {
            fprintf(stderr, "kernel_launch: unexpected shapes (n_in %d, in0 %d, out %d, ws %zu); nothing launched\n", n_in, n_in > 0 ? in_sizes[0] : -1, out_size, ws_size);
            grid = -1; return;
        }
        int dev = 0, cus = 0, per_cu = 0;
        if (hipGetDevice(&dev) != hipSuccess || hipDeviceGetAttribute(&cus, hipDeviceAttributeMultiprocessorCount, dev) != hipSuccess) { grid = -1; return; }
        if (hipOccupancyMaxActiveBlocksPerMultiprocessor(&per_cu, (const void*)mk_fwd, 256, 0) != hipSuccess) per_cu = 0;
        (void)hipGetLastError();
        if (per_cu < 2) fprintf(stderr, "kernel_launch: note: occupancy query reports %d workgroups per CU\n", per_cu);
        grid = cus * (per_cu >= 2 ? 2 : 1);
    }
    if (grid < 0) return;
    (void)hipMemsetAsync((char*)d_ws + WS_CTL, 0, CTL_BYTES + (size_t)M * 4, stream);
    Params p{};
    for (int i = 0; i < N_IN; ++i) p.in[i] = (const float*)d_in[i];
    p.out = (float*)d_out; p.ws = (unsigned char*)d_ws;
#if MK_N_LAUNCHES == 1
    p.ph_lo = 0; p.ph_hi = NPHASE;
    hipLaunchKernelGGL(mk_fwd, dim3(grid), dim3(256), 0, stream, p);
#else
    for (int ph = 0; ph < NPHASE; ++ph) { p.ph_lo = ph; p.ph_hi = ph + 1; hipLaunchKernelGGL(mk_fwd, dim3(grid), dim3(256), 0, stream, p); }
#endif
}
```
